# Optimizing an MI355X kernel written in HIP

```python
import math
import jax, jax.numpy as jnp
from jax import lax
import numpy as np

D_MODEL = 1024
BATCH = 2
SEQ = 8192
DEPTH = 2

MEM_LEN = 256
HG_HEADS = 8
HG_KDIM = 128
HG_VDIM = 128
HG_QK_W = HG_HEADS * HG_KDIM
HG_WIDTH = HG_HEADS * HG_VDIM
HG_CHUNK = 64
MLA_HEADS = 8
MLA_NOPE = 64
MLA_ROPE = 32
MLA_VDIM = 64
MLA_WIDTH = MLA_HEADS * MLA_VDIM
MLA_Q_RANK = 256
MLA_KV_RANK = 128
ROPE_THETA = 10000.0
Q_BLOCK = 128
MEM_HEADS = 4
MEM_HDIM = 128
MEM_WIDTH = MEM_HEADS * MEM_HDIM
MIX_WIDTH = HG_WIDTH + MLA_WIDTH + MEM_WIDTH
IN_SIZES = (HG_QK_W, HG_QK_W, HG_WIDTH, HG_WIDTH,
            MLA_Q_RANK, MLA_KV_RANK, MLA_ROPE, MLA_WIDTH,
            MEM_WIDTH, MEM_WIDTH)
IN_WIDTH = sum(IN_SIZES)
IN_OFFSETS = tuple(int(v) for v in np.cumsum(IN_SIZES)[:-1])
DEEPNORM_ALPHA = (2 * DEPTH) ** 0.25
DEEPNORM_BETA = (8 * DEPTH) ** -0.25
RMS_EPS = 1e-6
LN_EPS = 1e-5
NEG_BIG = -1e30

kernel_name = 'hymba_hgrn2_mla_mem_deepnorm'


def _rmsnorm(t, g):
    t32 = t.astype(jnp.float32)
    t32 = t32 * lax.rsqrt(jnp.mean(t32 * t32, axis=-1, keepdims=True) + RMS_EPS)
    return t32.astype(t.dtype) * g


def _layernorm(t, g, b):
    t32 = t.astype(jnp.float32)
    mu = jnp.mean(t32, axis=-1, keepdims=True)
    var = jnp.mean(jnp.square(t32 - mu), axis=-1, keepdims=True)
    return ((t32 - mu) * lax.rsqrt(var + LN_EPS)).astype(t.dtype) * g + b


def _rope(t, cos, sin):
    half = t.shape[-1] // 2
    t1, t2 = t[..., :half], t[..., half:]
    return jnp.concatenate([t1 * cos - t2 * sin, t1 * sin + t2 * cos], axis=-1)


def _chunk_gated_recurrence(q, k, v, logf):
    B, S, H, dk = q.shape
    dv = v.shape[-1]
    C = HG_CHUNK
    n = S // C

    def to_chunks(t):
        return t.reshape(B, n, C, H, t.shape[-1]).transpose(1, 0, 3, 2, 4)

    tri = jnp.tril(jnp.ones((C, C), dtype=jnp.float32))

    def step(state, inp):
        qc, kc, vc, gc = inp
        b = jnp.cumsum(gc, axis=2)
        diff = b[:, :, :, None, :] - b[:, :, None, :, :]
        decay = jnp.exp(jnp.minimum(diff, 0.0)) * tri[:, :, None]
        A = jnp.einsum('bhtsd,bhsd->bhts', qc[:, :, :, None, :] * decay, kc)
        o = (jnp.einsum('bhts,bhsv->bhtv', A, vc)
             + jnp.einsum('bhtd,bhdv->bhtv', qc * jnp.exp(b), state))
        b_last = b[:, :, -1:, :]
        state = (jnp.exp(b_last[:, :, 0, :])[..., None] * state
                 + jnp.einsum('bhsd,bhsv->bhdv', kc * jnp.exp(b_last - b), vc))
        return state, o

    state0 = jnp.zeros((B, H, dk, dv), jnp.float32)
    _, o = lax.scan(step, state0, (to_chunks(q), to_chunks(k), to_chunks(v), to_chunks(logf)))
    return o.transpose(1, 0, 3, 2, 4).reshape(B, S, H, dv)


def _hgrn2_group(q, f_pre, i, lb, out_g):
    B, S, _ = q.shape
    q32 = q.reshape(B, S, HG_HEADS, HG_KDIM).astype(jnp.float32)
    z = f_pre.reshape(B, S, HG_HEADS, HG_KDIM).astype(jnp.float32)
    lb = lb.reshape(HG_HEADS, HG_KDIM)
    logf = jax.nn.log_sigmoid(z) + jnp.log1p(lb * jnp.exp(-z))
    k = (1.0 - lb) * jax.nn.sigmoid(-z)
    v = i.reshape(B, S, HG_HEADS, HG_VDIM).astype(jnp.float32)
    o = _chunk_gated_recurrence(q32, k, v, logf)
    o = o * lax.rsqrt(jnp.mean(o * o, axis=-1, keepdims=True) + RMS_EPS)
    return (o.astype(q.dtype) * out_g).reshape(B, S, HG_WIDTH)


def _mla_group(cq, ckv, kr, q_norm, kv_norm, w_uq, w_uk, w_uv, cos, sin):
    B, S, _ = cq.shape
    q = (_rmsnorm(cq, q_norm) @ w_uq).reshape(B, S, MLA_HEADS, MLA_NOPE + MLA_ROPE)
    q_nope = q[..., :MLA_NOPE]
    q_rope = _rope(q[..., MLA_NOPE:], cos[:, :, None, :], sin[:, :, None, :])
    c = _rmsnorm(ckv, kv_norm)
    k_nope = (c @ w_uk).reshape(B, S, MLA_HEADS, MLA_NOPE)
    v = (c @ w_uv).reshape(B, S, MLA_HEADS, MLA_VDIM)
    k_rope = _rope(kr, cos, sin)
    scale = 1.0 / math.sqrt(MLA_NOPE + MLA_ROPE)
    nb = S // Q_BLOCK
    qn_b = q_nope.reshape(B, nb, Q_BLOCK, MLA_HEADS, MLA_NOPE).transpose(1, 0, 2, 3, 4)
    qr_b = q_rope.reshape(B, nb, Q_BLOCK, MLA_HEADS, MLA_ROPE).transpose(1, 0, 2, 3, 4)
    key_idx = jnp.arange(S)

    def attend(args):
        qn, qr, blk = args
        s = (jnp.einsum('bqhd,bkhd->bhqk', qn, k_nope)
             + jnp.einsum('bqhr,bkr->bhqk', qr, k_rope)).astype(jnp.float32) * scale
        q_idx = blk * Q_BLOCK + jnp.arange(Q_BLOCK)
        mask = key_idx[None, :] <= q_idx[:, None]
        s = jnp.where(mask, s, NEG_BIG)
        p = jax.nn.softmax(s, axis=-1).astype(v.dtype)
        return jnp.einsum('bhqk,bkhd->bqhd', p, v)

    o = lax.map(attend, (qn_b, qr_b, jnp.arange(nb)))
    return o.transpose(1, 0, 2, 3, 4).reshape(B, S, MLA_WIDTH)


def _memory_group(qm, mem, w_k, w_v):
    B, S, _ = qm.shape
    M = mem.shape[1]
    q = qm.reshape(B, S, MEM_HEADS, MEM_HDIM)
    k = (mem @ w_k).reshape(B, M, MEM_HEADS, MEM_HDIM)
    v = (mem @ w_v).reshape(B, M, MEM_HEADS, MEM_HDIM)
    s = jnp.einsum('bshd,bmhd->bhsm', q, k).astype(jnp.float32) / math.sqrt(MEM_HDIM)
    p = jax.nn.softmax(s, axis=-1).astype(v.dtype)
    return jnp.einsum('bhsm,bmhd->bshd', p, v).reshape(B, S, MEM_WIDTH)


def setup_inputs(seed: int = 0) -> dict:
    key = jax.random.key(seed)
    ks = jax.random.split(key, 16)
    nrm = jax.random.normal
    x = nrm(ks[0], (BATCH, SEQ, D_MODEL), jnp.float32)
    mem = nrm(ks[1], (BATCH, MEM_LEN, D_MODEL), jnp.float32)
    offsets = jax.random.randint(ks[2], (BATCH, 1), 0, 1024, dtype=jnp.int32)
    positions = (jnp.arange(SEQ, dtype=jnp.int32)[None, :] + offsets).astype(jnp.int32)
    w_in = nrm(ks[3], (DEPTH, D_MODEL, IN_WIDTH)) * D_MODEL ** -0.5
    hgrn_lb_logits = 0.1 * nrm(ks[4], (DEPTH, HG_QK_W))
    hgrn_out_norm = 1.0 + 0.02 * nrm(ks[5], (DEPTH, HG_VDIM))
    mla_q_norm = 1.0 + 0.02 * nrm(ks[6], (DEPTH, MLA_Q_RANK))
    mla_kv_norm = 1.0 + 0.02 * nrm(ks[7], (DEPTH, MLA_KV_RANK))
    w_mla_uq = nrm(ks[8], (DEPTH, MLA_Q_RANK, MLA_HEADS * (MLA_NOPE + MLA_ROPE))) * MLA_Q_RANK ** -0.5
    w_mla_uk = nrm(ks[9], (DEPTH, MLA_KV_RANK, MLA_HEADS * MLA_NOPE)) * MLA_KV_RANK ** -0.5
    w_mla_uv = nrm(ks[10], (DEPTH, MLA_KV_RANK, MLA_WIDTH)) * (MLA_KV_RANK ** -0.5 * DEEPNORM_BETA)
    w_mem_k = nrm(ks[11], (DEPTH, D_MODEL, MEM_WIDTH)) * D_MODEL ** -0.5
    w_mem_v = nrm(ks[12], (DEPTH, D_MODEL, MEM_WIDTH)) * (D_MODEL ** -0.5 * DEEPNORM_BETA)
    w_out = nrm(ks[13], (DEPTH, MIX_WIDTH, D_MODEL)) * (MIX_WIDTH ** -0.5 * DEEPNORM_BETA)
    ln_g = 1.0 + 0.02 * nrm(ks[14], (DEPTH, D_MODEL))
    ln_b = 0.02 * nrm(ks[15], (DEPTH, D_MODEL))
    return {'x': x, 'mem': mem, 'positions': positions, 'w_in': w_in,
            'hgrn_lb_logits': hgrn_lb_logits, 'hgrn_out_norm': hgrn_out_norm,
            'mla_q_norm': mla_q_norm, 'mla_kv_norm': mla_kv_norm,
            'w_mla_uq': w_mla_uq, 'w_mla_uk': w_mla_uk, 'w_mla_uv': w_mla_uv,
            'w_mem_k': w_mem_k, 'w_mem_v': w_mem_v, 'w_out': w_out,
            'ln_g': ln_g, 'ln_b': ln_b}


def reference(x, mem, positions, w_in, hgrn_lb_logits, hgrn_out_norm, mla_q_norm,
              mla_kv_norm, w_mla_uq, w_mla_uk, w_mla_uv, w_mem_k, w_mem_v, w_out,
              ln_g, ln_b):
    inv_freq = 1.0 / (ROPE_THETA ** (jnp.arange(0, MLA_ROPE, 2, dtype=jnp.float32) / MLA_ROPE))
    ang = positions.astype(jnp.float32)[..., None] * inv_freq
    cos = jnp.cos(ang).astype(x.dtype)
    sin = jnp.sin(ang).astype(x.dtype)
    lb_soft = jax.nn.softmax(hgrn_lb_logits.astype(jnp.float32), axis=0)
    lower_bounds = jnp.cumsum(lb_soft, axis=0) - lb_soft[0]

    for l in range(DEPTH):
        h = x @ w_in[l]
        (hg_q, hg_f, hg_i, hg_gate, mla_cq, mla_ckv, mla_kr, mla_gate,
         mem_q, mem_gate) = jnp.split(h, IN_OFFSETS, axis=-1)
        y_hg = _hgrn2_group(hg_q, hg_f, hg_i, lower_bounds[l], hgrn_out_norm[l])
        y_mla = _mla_group(mla_cq, mla_ckv, mla_kr, mla_q_norm[l], mla_kv_norm[l],
                           w_mla_uq[l], w_mla_uk[l], w_mla_uv[l], cos, sin)
        y_mem = _memory_group(mem_q, mem, w_mem_k[l], w_mem_v[l])
        y = jnp.concatenate([y_hg * jax.nn.silu(hg_gate),
                             y_mla * jax.nn.silu(mla_gate),
                             y_mem * jax.nn.silu(mem_gate)], axis=-1)
        y = y @ w_out[l]
        x = _layernorm(DEEPNORM_ALPHA * x + y, ln_g[l], ln_b[l])
    return x
```

```cpp
#include <hip/hip_runtime.h>
#include <hip/hip_cooperative_groups.h>
#include <cstdio>
#include <cstdint>

#define GAS __attribute__((address_space(1)))
#define LAS __attribute__((address_space(3)))
typedef unsigned short bf16_t;
typedef unsigned v4u __attribute__((ext_vector_type(4)));
typedef unsigned v2u __attribute__((ext_vector_type(2)));
typedef float f32x4 __attribute__((ext_vector_type(4)));

constexpr int NB = 2, SEQ = 8192, T = NB * SEQ, DM = 1024, DEPTH = 2, MEML = 256;
constexpr int INW = 6048, MIXW = 2048, NWIN = 6144;
constexpr int G2_ROW0 = 0, G2_N = 4096, G1_ROW0 = 4096, G1_N = 2048;
constexpr int CHUNK = 64, NCH = SEQ / CHUNK;
constexpr float ALPHA = 1.4142135623730951f;
constexpr float RMS_EPS = 1e-6f, LN_EPS = 1e-5f;
constexpr float LOG2E = 1.4426950408889634f;
constexpr float C2_MLA = LOG2E * 0.10206207261596575f;
constexpr float C2_MEM = LOG2E * 0.08838834764831845f;

constexpr size_t MiB = 1u << 20;
constexpr size_t WS_CTL = 0, CTL_BYTES = 1 * MiB;
constexpr size_t WS_WIN = 1 * MiB;
constexpr size_t WS_WOUT = 13 * MiB;
constexpr size_t WS_WUQ = 17 * MiB;
constexpr size_t WS_WUK = 18 * MiB;
constexpr size_t WS_WUV = 18 * MiB + 512 * 1024;
constexpr size_t WS_KMEM = 19 * MiB;
constexpr size_t WS_VMEMT = 20 * MiB;
constexpr size_t WS_COS = 21 * MiB, WS_SIN = 22 * MiB;
constexpr size_t WS_SSQ_CQ = 23 * MiB, WS_SSQ_CKV = 23 * MiB + 256 * 1024;
constexpr size_t WS_LB = 23 * MiB + 512 * 1024;
constexpr size_t WS_DECAY = 24 * MiB;
constexpr size_t WS_XN = 25 * MiB;
constexpr size_t WS_MIX = 57 * MiB;
constexpr size_t WS_R1 = 121 * MiB;
constexpr size_t WS_R2 = 153 * MiB;
constexpr size_t WS_R3 = 217 * MiB;
constexpr size_t WS_END = 249 * MiB;
constexpr size_t R2_KN = 0, R2_VT = 16 * MiB, R2_KR = 32 * MiB;
constexpr size_t R3_CQ = 0, R3_CKV = 8 * MiB, R3_KRRAW = 12 * MiB, R3_MEMQ = 14 * MiB;

__device__ __forceinline__ unsigned f2bf(float f) { unsigned u = __builtin_bit_cast(unsigned, f); return (u + 0x7fffu + ((u >> 16) & 1u)) >> 16; }
__device__ __forceinline__ float bf2f(unsigned short b) { return __builtin_bit_cast(float, (unsigned)b << 16); }
__device__ __forceinline__ unsigned pk2(float lo, float hi) { return f2bf(lo) | (f2bf(hi) << 16); }
__device__ __forceinline__ float silu_f(float v) { return v / (1.0f + __expf(-v)); }

struct Ptrs {
    const float *x, *mem; const int* pos; const float *w_in, *lb_logits, *out_norm, *q_norm, *kv_norm, *w_uq, *w_uk, *w_uv, *w_mk, *w_mv, *w_out, *ln_g, *ln_b;
    float* out; unsigned char* ws;
};

__device__ __forceinline__ int cmap_win(int n) {
    if (n < 4480) return n;
    if (n < 4512) { const int i = n - 4480; return 4480 + ((i & 1) ? 16 + (i >> 1) : (i >> 1)); }
    if (n < 4608) return -1;
    return n - 96;
}
__device__ __forceinline__ int cmap_wuq(int n) {
    const int h = n / 96, j = n - h * 96;
    if (j < 64) return n;
    const int i = j - 64; return h * 96 + 64 + ((i & 1) ? 16 + (i >> 1) : (i >> 1));
}
__device__ __forceinline__ int cmap_id(int n) { return n; }
template <int MAPK>
__device__ __forceinline__ void transpose_item(const float* W, int K, int Nsrc, int Ndst, const float* kscale, bf16_t* WT, LAS float* scr, int item, int lane) {
    const int nblk = Ndst / 32, kb = item / nblk, nb = item % nblk, k0 = 64 * kb, n0 = 32 * nb;
    const int n = n0 + (lane & 31);
    const int c = MAPK == 0 ? cmap_id(n) : (MAPK == 1 ? cmap_win(n) : cmap_wuq(n));
#pragma unroll 8
    for (int i = 0; i < 32; ++i) { const int kk = 2 * i + (lane >> 5); float v = 0.f; if (c >= 0) { v = W[(size_t)(k0 + kk) * Nsrc + c]; if (kscale) v *= kscale[k0 + kk]; } scr[kk * 33 + (lane & 31)] = v; }
    asm volatile("s_waitcnt lgkmcnt(0)" ::: "memory");
    const int cc = lane & 7;
#pragma unroll
    for (int j = 0; j < 4; ++j) { const int nn = (lane >> 3) + 8 * j; const LAS float* s = scr + (8 * cc) * 33 + nn;
        v4u o; o.x = pk2(s[0 * 33], s[1 * 33]); o.y = pk2(s[2 * 33], s[3 * 33]); o.z = pk2(s[4 * 33], s[5 * 33]); o.w = pk2(s[6 * 33], s[7 * 33]);
        *(v4u*)(WT + (size_t)(n0 + nn) * K + k0 + 8 * cc) = o; }
    asm volatile("s_waitcnt lgkmcnt(0)" ::: "memory");
}

constexpr int NTHR = 512, NWAVES = 8;
constexpr int LDS_BYTES = 147456;
enum { PH_PRO = 0, PH_LN = 1 };
struct Args { Ptrs p; int phase, layer; };

__device__ __forceinline__ float wave_sum(float v) {
#pragma unroll
    for (int o = 1; o < 64; o <<= 1) v += __shfl_xor(v, o);
    return v;
}

__device__ __forceinline__ void conv_layer_weights(const Ptrs& p, int l, LAS float* scr, int gw, int ngw, int lane) {
    constexpr int I_IN = (DM / 64) * (NWIN / 32), I_OUT = (MIXW / 64) * (DM / 32);
    bf16_t* win = (bf16_t*)(p.ws + WS_WIN); bf16_t* wout = (bf16_t*)(p.ws + WS_WOUT);
    for (int it = gw; it < I_IN + I_OUT; it += ngw) {
        if (it < I_IN) transpose_item<1>(p.w_in + (size_t)l * DM * INW, DM, INW, NWIN, nullptr, win, scr, it, lane);
        else transpose_item<0>(p.w_out + (size_t)l * MIXW * DM, MIXW, DM, DM, nullptr, wout, scr, it - I_IN, lane);
    }
}

__device__ __forceinline__ void phase_prologue(const Ptrs& p, LAS unsigned char* lds, int gw, int ngw, int wave, int lane) {
    LAS float* scr = (LAS float*)(lds + wave * 16384);
    conv_layer_weights(p, 0, scr, gw, ngw, lane);
    {
        constexpr int I_UQ = (256 / 64) * (768 / 32), I_UK = (128 / 64) * (512 / 32);
        for (int it = gw; it < 2 * (I_UQ + 2 * I_UK); it += ngw) {
            const int l = it / (I_UQ + 2 * I_UK); int r = it % (I_UQ + 2 * I_UK);
            if (r < I_UQ) { transpose_item<2>(p.w_uq + (size_t)l * 256 * 768, 256, 768, 768, p.q_norm + l * 256, (bf16_t*)(p.ws + WS_WUQ) + (size_t)l * 768 * 256, scr, r, lane); continue; } r -= I_UQ;
            if (r < I_UK) { transpose_item<0>(p.w_uk + (size_t)l * 128 * 512, 128, 512, 512, p.kv_norm + l * 128, (bf16_t*)(p.ws + WS_WUK) + (size_t)l * 512 * 128, scr, r, lane); continue; } r -= I_UK;
            transpose_item<0>(p.w_uv + (size_t)l * 128 * 512, 128, 512, 512, p.kv_norm + l * 128, (bf16_t*)(p.ws + WS_WUV) + (size_t)l * 512 * 128, scr, r, lane);
        }
    }
    for (int m = gw; m < T; m += ngw) {
        const f32x4* xr = (const f32x4*)(p.x + (size_t)m * DM) + lane; v2u* o = (v2u*)((bf16_t*)(p.ws + WS_XN) + (size_t)m * DM) + lane;
#pragma unroll
        for (int j = 0; j < 4; ++j) { const f32x4 v = xr[64 * j]; v2u w; w.x = pk2(v.x, v.y); w.y = pk2(v.z, v.w); o[64 * j] = w; }
    }
    const int gt = gw * 64 + lane, ngt = ngw * 64;
    for (int i = gt; i < T * 16; i += ngt) {
        const int t = i >> 4, j = i & 15;
        const double inv = pow(10000.0, -(double)j / 16.0); const double ang = (double)p.pos[t] * inv;
        ((float*)(p.ws + WS_COS))[i] = (float)cos(ang); ((float*)(p.ws + WS_SIN))[i] = (float)sin(ang);
    }
    for (int i = gt; i < 1024; i += ngt) {
        float* lb = (float*)(p.ws + WS_LB); lb[i] = 0.f;
        const float a = p.lb_logits[i], b = p.lb_logits[1024 + i]; lb[1024 + i] = 1.0f / (1.0f + expf(a - b));
    }
    for (int i = gt; i < 2 * 2 * 512 * 512; i += ngt) {
        const int c = i & 511, r = (i >> 9) & 511, kv = (i >> 18) & 1, l = i >> 19;
        const float* w = (kv ? p.w_mv : p.w_mk) + (size_t)l * 1024 * 512 + c; const float* mr = p.mem + (size_t)r * 1024;
        float acc = 0.f;
        for (int k = 0; k < 1024; ++k) acc = fmaf(mr[k], w[(size_t)k * 512], acc);
        const int b = r >> 8, m = r & 255, h = c >> 7, d = c & 127;
        if (kv == 0) ((bf16_t*)(p.ws + WS_KMEM))[((size_t)((l * 2 + b) * 4 + h) * 256 + m) * 128 + d] = (bf16_t)f2bf(acc);
        else ((bf16_t*)(p.ws + WS_VMEMT))[((size_t)((l * 2 + b) * 4 + h) * 128 + d) * 256 + m] = (bf16_t)f2bf(acc);
    }
}

__device__ __forceinline__ void phase_ln(const Ptrs& p, int l, LAS unsigned char* lds, int gw, int ngw, int wave, int lane) {
    const float* g = p.ln_g + l * DM; const float* bt = p.ln_b + l * DM;
    for (int m = gw; m < T; m += ngw) {
        f32x4* xr = (f32x4*)(p.out + (size_t)m * DM) + lane;
        f32x4 v[4]; float s = 0.f;
#pragma unroll
        for (int j = 0; j < 4; ++j) { v[j] = xr[64 * j]; s += (v[j].x + v[j].y) + (v[j].z + v[j].w); }
        const float mean = wave_sum(s) * (1.f / DM); float s2 = 0.f;
#pragma unroll
        for (int j = 0; j < 4; ++j) { v[j] = v[j] - mean; s2 += (v[j].x * v[j].x + v[j].y * v[j].y) + (v[j].z * v[j].z + v[j].w * v[j].w); }
        const float rstd = 1.f / sqrtf(wave_sum(s2) * (1.f / DM) + LN_EPS);
        v2u* o = (v2u*)((bf16_t*)(p.ws + WS_XN) + (size_t)m * DM) + lane;
#pragma unroll
        for (int j = 0; j < 4; ++j) {
            const f32x4 gg = *((const f32x4*)g + lane + 64 * j), bb = *((const f32x4*)bt + lane + 64 * j);
            const f32x4 y = v[j] * rstd * gg + bb; xr[64 * j] = y;
            v2u w; w.x = pk2(y.x, y.y); w.y = pk2(y.z, y.w); o[64 * j] = w;
        }
    }
    if (l + 1 < DEPTH) conv_layer_weights(p, l + 1, (LAS float*)(lds + wave * 16384), gw, ngw, lane);
}

__global__ void __launch_bounds__(NTHR, 2) mk(Args a) {
    extern __shared__ __attribute__((aligned(16))) unsigned char lds_raw[];
    LAS unsigned char* lds = (LAS unsigned char*)lds_raw;
    const int tid = threadIdx.x, lane = tid & 63, wave = __builtin_amdgcn_readfirstlane(tid >> 6);
    const int gw = blockIdx.x * NWAVES + wave, ngw = gridDim.x * NWAVES;
    if (a.phase == PH_PRO) phase_prologue(a.p, lds, gw, ngw, wave, lane);
    else if (a.phase == PH_LN) phase_ln(a.p, a.layer, lds, gw, ngw, wave, lane);
}

template <class Epi>
__global__ void __launch_bounds__(256) naive_gemm(const bf16_t* A, int lda, const bf16_t* Bt, int ldb, int K, Epi epi) {
    __shared__ float As[16][68], Bs[16][68];
    const int tid = threadIdx.x, tx = tid & 15, ty = tid >> 4;
    const int m0 = blockIdx.y * 64, n0 = blockIdx.x * 64;
    float acc[4][4];
#pragma unroll
    for (int i = 0; i < 4; ++i)
#pragma unroll
        for (int j = 0; j < 4; ++j) acc[i][j] = 0.f;
    const int lr = tid >> 2, lk = (tid & 3) * 4;
    for (int k0 = 0; k0 < K; k0 += 16) {
        const v2u av = *(const v2u*)(A + (size_t)(m0 + lr) * lda + k0 + lk);
        const v2u bv = *(const v2u*)(Bt + (size_t)(n0 + lr) * ldb + k0 + lk);
        __syncthreads();
        As[lk + 0][lr] = bf2f(av.x & 0xffff); As[lk + 1][lr] = bf2f(av.x >> 16); As[lk + 2][lr] = bf2f(av.y & 0xffff); As[lk + 3][lr] = bf2f(av.y >> 16);
        Bs[lk + 0][lr] = bf2f(bv.x & 0xffff); Bs[lk + 1][lr] = bf2f(bv.x >> 16); Bs[lk + 2][lr] = bf2f(bv.y & 0xffff); Bs[lk + 3][lr] = bf2f(bv.y >> 16);
        __syncthreads();
#pragma unroll
        for (int k = 0; k < 16; ++k) {
            float a[4], b[4];
#pragma unroll
            for (int i = 0; i < 4; ++i) { a[i] = As[k][ty * 4 + i]; b[i] = Bs[k][tx * 4 + i]; }
#pragma unroll
            for (int i = 0; i < 4; ++i)
#pragma unroll
                for (int j = 0; j < 4; ++j) acc[i][j] = fmaf(a[i], b[j], acc[i][j]);
        }
    }
#pragma unroll
    for (int i = 0; i < 4; ++i) epi(m0 + ty * 4 + i, n0 + tx * 4, acc[i]);
}

struct EpiG1 {
    unsigned char* ws;
    __device__ __forceinline__ void operator()(int row, int col, const float (&v)[4]) const {
        const int pn = col >> 8, c = col & 255;
        if (pn == 0) {
            *(v2u*)((bf16_t*)(ws + WS_R3 + R3_CQ) + (size_t)row * 256 + c) = (v2u){pk2(v[0], v[1]), pk2(v[2], v[3])};
            float s = v[0] * v[0] + v[1] * v[1] + v[2] * v[2] + v[3] * v[3];
            s += __shfl_xor(s, 1); s += __shfl_xor(s, 2); s += __shfl_xor(s, 4); s += __shfl_xor(s, 8);
            if ((threadIdx.x & 15) == 0) ((float*)(ws + WS_SSQ_CQ))[(size_t)row * 4 + (c >> 6)] = s;
        } else if (pn == 1) {
            if (c < 128) {
                *(v2u*)((bf16_t*)(ws + WS_R3 + R3_CKV) + (size_t)row * 128 + c) = (v2u){pk2(v[0], v[1]), pk2(v[2], v[3])};
                float s = v[0] * v[0] + v[1] * v[1] + v[2] * v[2] + v[3] * v[3];
                s += __shfl_xor(s, 1); s += __shfl_xor(s, 2); s += __shfl_xor(s, 4); s += __shfl_xor(s, 8);
                if ((threadIdx.x & 15) == 0) { float* q = (float*)(ws + WS_SSQ_CKV) + (size_t)row * 4; q[c >> 6] = s; q[2 + (c >> 6)] = 0.f; }
            } else if (c < 160) {
                *(f32x4*)((float*)(ws + WS_R3 + R3_KRRAW) + (size_t)row * 32 + (c - 128)) = (f32x4){v[0], v[1], v[2], v[3]};
            }
        } else if (pn < 4) {
            *(v2u*)((bf16_t*)(ws + WS_MIX) + (size_t)row * MIXW + 1024 + (col - 512)) = (v2u){pk2(silu_f(v[0]), silu_f(v[1])), pk2(silu_f(v[2]), silu_f(v[3]))};
        } else if (pn < 6) {
            *(v2u*)((bf16_t*)(ws + WS_R3 + R3_MEMQ) + (size_t)row * 512 + (col - 1024)) = (v2u){pk2(v[0] * C2_MEM, v[1] * C2_MEM), pk2(v[2] * C2_MEM, v[3] * C2_MEM)};
        } else {
            *(v2u*)((bf16_t*)(ws + WS_MIX) + (size_t)row * MIXW + 1536 + (col - 1536)) = (v2u){pk2(silu_f(v[0]), silu_f(v[1])), pk2(silu_f(v[2]), silu_f(v[3]))};
        }
    }
};
struct EpiG2 {
    unsigned char* ws;
    __device__ __forceinline__ void operator()(int row, int col, const float (&v)[4]) const {
        const int seg = col >> 10, c = col & 1023;
        if (seg == 0) *(v2u*)((bf16_t*)(ws + WS_R1) + (size_t)row * 1024 + c) = (v2u){pk2(v[0], v[1]), pk2(v[2], v[3])};
        else if (seg == 1) *(f32x4*)((float*)(ws + WS_R2) + (size_t)row * 1024 + c) = (f32x4){v[0], v[1], v[2], v[3]};
        else if (seg == 2) *(v2u*)((bf16_t*)(ws + WS_R3) + (size_t)row * 1024 + c) = (v2u){pk2(v[0], v[1]), pk2(v[2], v[3])};
        else *(v2u*)((bf16_t*)(ws + WS_MIX) + (size_t)row * MIXW + c) = (v2u){pk2(silu_f(v[0]), silu_f(v[1])), pk2(silu_f(v[2]), silu_f(v[3]))};
    }
};
__device__ __forceinline__ float rstd4(const float* q, float n) { return 1.0f / sqrtf(((q[0] + q[1]) + (q[2] + q[3])) * (1.0f / n) + RMS_EPS); }
struct EpiQ {
    unsigned char* ws;
    __device__ __forceinline__ void operator()(int row, int col, const float (&v)[4]) const {
        const float r = rstd4((const float*)(ws + WS_SSQ_CQ) + (size_t)row * 4, 256.f) * C2_MLA;
        const int h = col / 96, j = col - h * 96;
        float o[4] = {v[0] * r, v[1] * r, v[2] * r, v[3] * r};
        if (j >= 64) {
            const int i0 = (j - 64) >> 1; const float* cs = (const float*)(ws + WS_COS) + (size_t)row * 16; const float* sn = (const float*)(ws + WS_SIN) + (size_t)row * 16;
            const float a0 = o[0], b0 = o[1], a1 = o[2], b1 = o[3];
            o[0] = a0 * cs[i0] - b0 * sn[i0]; o[1] = a0 * sn[i0] + b0 * cs[i0];
            o[2] = a1 * cs[i0 + 1] - b1 * sn[i0 + 1]; o[3] = a1 * sn[i0 + 1] + b1 * cs[i0 + 1];
        }
        *(v2u*)((bf16_t*)(ws + WS_R1) + (size_t)row * 768 + col) = (v2u){pk2(o[0], o[1]), pk2(o[2], o[3])};
    }
};
struct EpiKn {
    unsigned char* ws;
    __device__ __forceinline__ void operator()(int row, int col, const float (&v)[4]) const {
        const float r = rstd4((const float*)(ws + WS_SSQ_CKV) + (size_t)row * 4, 128.f);
        *(v2u*)((bf16_t*)(ws + WS_R2 + R2_KN) + (size_t)row * 512 + col) = (v2u){pk2(v[0] * r, v[1] * r), pk2(v[2] * r, v[3] * r)};
    }
};
struct EpiVt {
    unsigned char* ws;
    __device__ __forceinline__ void operator()(int row, int col, const float (&v)[4]) const {
        float o[4];
#pragma unroll
        for (int i = 0; i < 4; ++i) o[i] = v[i] * rstd4((const float*)(ws + WS_SSQ_CKV) + (size_t)(col + i) * 4, 128.f);
        const int b = col >> 13, s = col & (SEQ - 1);
        *(v2u*)((bf16_t*)(ws + WS_R2 + R2_VT) + ((size_t)(b * 512 + row)) * SEQ + s) = (v2u){pk2(o[0], o[1]), pk2(o[2], o[3])};
    }
};
struct EpiOut {
    const float* xres; float* out;
    __device__ __forceinline__ void operator()(int row, int col, const float (&v)[4]) const {
        const f32x4 xr = *(const f32x4*)(xres + (size_t)row * DM + col);
        *(f32x4*)(out + (size_t)row * DM + col) = (f32x4){ALPHA * xr.x + v[0], ALPHA * xr.y + v[1], ALPHA * xr.z + v[2], ALPHA * xr.w + v[3]};
    }
};

__global__ void naive_krope(unsigned char* ws) {
    const int i = blockIdx.x * blockDim.x + threadIdx.x; if (i >= T * 16) return;
    const int t = i >> 4, j = i & 15;
    const float* raw = (const float*)(ws + WS_R3 + R3_KRRAW) + (size_t)t * 32 + 2 * j;
    const float c = ((const float*)(ws + WS_COS))[i], s = ((const float*)(ws + WS_SIN))[i];
    const float a = raw[0], b = raw[1];
    *(unsigned*)((bf16_t*)(ws + WS_R2 + R2_KR) + (size_t)t * 32 + 2 * j) = pk2(a * c - b * s, a * s + b * c);
}

__global__ void __launch_bounds__(64) naive_mla_attn(unsigned char* ws) {
    __shared__ float Ks[32][96], Vs[32][64];
    const int qb = blockIdx.x, h = blockIdx.y, b = blockIdx.z, tid = threadIdx.x;
    const int qi = qb * 64 + tid; const size_t row = (size_t)b * SEQ + qi;
    const bf16_t* Q = (const bf16_t*)(ws + WS_R1) + row * 768 + h * 96;
    const bf16_t* KN = (const bf16_t*)(ws + WS_R2 + R2_KN); const bf16_t* KR = (const bf16_t*)(ws + WS_R2 + R2_KR);
    const bf16_t* VT = (const bf16_t*)(ws + WS_R2 + R2_VT) + (size_t)(b * 512 + h * 64) * SEQ;
    float q[96], o[64];
#pragma unroll
    for (int d = 0; d < 96; ++d) q[d] = bf2f(Q[d]);
#pragma unroll
    for (int d = 0; d < 64; ++d) o[d] = 0.f;
    float m = -1e30f, l = 0.f;
    const int nk = qb * 64 + 64;
    for (int k0 = 0; k0 < nk; k0 += 32) {
        __syncthreads();
        for (int i = tid; i < 32 * 96; i += 64) { const int kk = i / 96, d = i - kk * 96; const size_t kr = (size_t)b * SEQ + k0 + kk;
            Ks[kk][d] = d < 64 ? bf2f(KN[kr * 512 + h * 64 + d]) : bf2f(KR[kr * 32 + (d - 64)]); }
        for (int i = tid; i < 32 * 64; i += 64) { const int d = i >> 5, kk = i & 31; Vs[kk][d] = bf2f(VT[(size_t)d * SEQ + k0 + kk]); }
        __syncthreads();
        for (int kk = 0; kk < 32; ++kk) {
            if (k0 + kk > qi) break;
            float s = 0.f;
#pragma unroll
            for (int d = 0; d < 96; ++d) s = fmaf(q[d], Ks[kk][d], s);
            const float mn = fmaxf(m, s), al = exp2f(m - mn), pp = exp2f(s - mn);
            l = l * al + pp; m = mn;
#pragma unroll
            for (int d = 0; d < 64; ++d) o[d] = fmaf(pp, Vs[kk][d], o[d] * al);
        }
    }
    bf16_t* mix = (bf16_t*)(ws + WS_MIX) + row * MIXW + 1024 + h * 64; const float il = 1.0f / l;
#pragma unroll
    for (int d = 0; d < 64; ++d) mix[d] = (bf16_t)f2bf(o[d] * il * bf2f(mix[d]));
}
__global__ void __launch_bounds__(64) naive_mem_attn(unsigned char* ws, int l) {
    __shared__ float Ks[16][128], Vs[16][64];
    const int qb = blockIdx.x, h = blockIdx.y >> 1, vh = blockIdx.y & 1, b = blockIdx.z, tid = threadIdx.x;
    const size_t row = (size_t)b * SEQ + qb * 64 + tid;
    const bf16_t* Q = (const bf16_t*)(ws + WS_R3 + R3_MEMQ) + row * 512 + h * 128;
    const bf16_t* KM = (const bf16_t*)(ws + WS_KMEM) + (size_t)((l * 2 + b) * 4 + h) * 256 * 128;
    const bf16_t* VM = (const bf16_t*)(ws + WS_VMEMT) + (size_t)((l * 2 + b) * 4 + h) * 128 * 256 + (size_t)vh * 64 * 256;
    float q[128], o[64];
#pragma unroll
    for (int d = 0; d < 128; ++d) q[d] = bf2f(Q[d]);
#pragma unroll
    for (int d = 0; d < 64; ++d) o[d] = 0.f;
    float m = -1e30f, lsum = 0.f;
    for (int k0 = 0; k0 < 256; k0 += 16) {
        __syncthreads();
        for (int i = tid; i < 16 * 128; i += 64) { const int kk = i >> 7, d = i & 127; Ks[kk][d] = bf2f(KM[(size_t)(k0 + kk) * 128 + d]); }
        for (int i = tid; i < 16 * 64; i += 64) { const int d = i >> 4, kk = i & 15; Vs[kk][d] = bf2f(VM[(size_t)d * 256 + k0 + kk]); }
        __syncthreads();
        for (int kk = 0; kk < 16; ++kk) {
            float s = 0.f;
#pragma unroll
            for (int d = 0; d < 128; ++d) s = fmaf(q[d], Ks[kk][d], s);
            const float mn = fmaxf(m, s), al = exp2f(m - mn), pp = exp2f(s - mn);
            lsum = lsum * al + pp; m = mn;
#pragma unroll
            for (int d = 0; d < 64; ++d) o[d] = fmaf(pp, Vs[kk][d], o[d] * al);
        }
    }
    bf16_t* mix = (bf16_t*)(ws + WS_MIX) + row * MIXW + 1536 + h * 128 + vh * 64; const float il = 1.0f / lsum;
#pragma unroll
    for (int d = 0; d < 64; ++d) mix[d] = (bf16_t)f2bf(o[d] * il * bf2f(mix[d]));
}

__global__ void __launch_bounds__(512) naive_hgrn(unsigned char* ws, const float* out_g, int l) {
    __shared__ float F[16][128], Kk[16][128], Qq[16][128], Vv[16][128], PO[16][4][128];
    const int h = blockIdx.x & 7, b = blockIdx.x >> 3, tid = threadIdx.x, e = tid & 127, dq = tid >> 7;
    const bf16_t* QB = (const bf16_t*)(ws + WS_R1); const float* ZB = (const float*)(ws + WS_R2); const bf16_t* VB = (const bf16_t*)(ws + WS_R3);
    const float* lbp = (const float*)(ws + WS_LB) + l * 1024 + h * 128;
    float st[32];
#pragma unroll
    for (int i = 0; i < 32; ++i) st[i] = 0.f;
    for (int t0 = 0; t0 < SEQ; t0 += 16) {
        for (int i = tid; i < 16 * 128; i += 512) {
            const int tt = i >> 7, d = i & 127; const size_t off = ((size_t)b * SEQ + t0 + tt) * 1024 + h * 128 + d;
            const float z = ZB[off], lb = lbp[d], sg = 1.0f / (1.0f + expf(-z));
            F[tt][d] = lb + (1.0f - lb) * sg; Kk[tt][d] = (1.0f - lb) * (1.0f - sg); Qq[tt][d] = bf2f(QB[off]); Vv[tt][d] = bf2f(VB[off]);
        }
        __syncthreads();
        for (int tt = 0; tt < 16; ++tt) {
            const float v = Vv[tt][e]; float po = 0.f;
#pragma unroll
            for (int i = 0; i < 32; ++i) { const int d = dq * 32 + i; st[i] = fmaf(F[tt][d], st[i], Kk[tt][d] * v); po = fmaf(Qq[tt][d], st[i], po); }
            PO[tt][dq][e] = po;
        }
        __syncthreads();
        {
            const int tt = tid >> 5, e4 = (tid & 31) * 4; float o[4]; float ss = 0.f;
#pragma unroll
            for (int j = 0; j < 4; ++j) { o[j] = (PO[tt][0][e4 + j] + PO[tt][1][e4 + j]) + (PO[tt][2][e4 + j] + PO[tt][3][e4 + j]); ss += o[j] * o[j]; }
            ss += __shfl_xor(ss, 1); ss += __shfl_xor(ss, 2); ss += __shfl_xor(ss, 4); ss += __shfl_xor(ss, 8); ss += __shfl_xor(ss, 16);
            const float r = 1.0f / sqrtf(ss * (1.0f / 128.0f) + RMS_EPS);
            bf16_t* mix = (bf16_t*)(ws + WS_MIX) + ((size_t)b * SEQ + t0 + tt) * MIXW + h * 128 + e4;
            const v2u gt = *(const v2u*)mix;
            const float g0 = bf2f(gt.x & 0xffff), g1 = bf2f(gt.x >> 16), g2 = bf2f(gt.y & 0xffff), g3 = bf2f(gt.y >> 16);
            *(v2u*)mix = (v2u){pk2(o[0] * r * out_g[e4] * g0, o[1] * r * out_g[e4 + 1] * g1), pk2(o[2] * r * out_g[e4 + 2] * g2, o[3] * r * out_g[e4 + 3] * g3)};
        }
        __syncthreads();
    }
}

extern "C" void kernel_launch(void* const* d_in, const int* in_sizes, int n_in, void* d_out, int out_size, void* d_ws, size_t ws_size, hipStream_t stream) {
    static int ok = 0;
    if (ok == 0) {
        if (n_in != 16 || in_sizes[0] != T * DM || out_size != T * DM || ws_size < WS_END) { fprintf(stderr, "kernel_launch: unexpected shapes (n_in %d, ws %zu)\n", n_in, ws_size); ok = -1; return; }
        if (hipFuncSetAttribute((const void*)mk, hipFuncAttributeMaxDynamicSharedMemorySize, LDS_BYTES) != hipSuccess) { fprintf(stderr, "kernel_launch: hipFuncSetAttribute failed\n"); ok = -1; return; }
        ok = 1;
    }
    if (ok < 0) return;
    Args a{};
    a.p.x = (const float*)d_in[0]; a.p.mem = (const float*)d_in[1]; a.p.pos = (const int*)d_in[2]; a.p.w_in = (const float*)d_in[3];
    a.p.lb_logits = (const float*)d_in[4]; a.p.out_norm = (const float*)d_in[5]; a.p.q_norm = (const float*)d_in[6]; a.p.kv_norm = (const float*)d_in[7];
    a.p.w_uq = (const float*)d_in[8]; a.p.w_uk = (const float*)d_in[9]; a.p.w_uv = (const float*)d_in[10]; a.p.w_mk = (const float*)d_in[11]; a.p.w_mv = (const float*)d_in[12];
    a.p.w_out = (const float*)d_in[13]; a.p.ln_g = (const float*)d_in[14]; a.p.ln_b = (const float*)d_in[15];
    a.p.out = (float*)d_out; a.p.ws = (unsigned char*)d_ws;
    unsigned char* ws = (unsigned char*)d_ws;
    const int G = 256;
    a.phase = PH_PRO; a.layer = 0;
    hipLaunchKernelGGL(mk, dim3(G), dim3(NTHR), LDS_BYTES, stream, a);
    const bf16_t* XN = (const bf16_t*)(ws + WS_XN); const bf16_t* WIN = (const bf16_t*)(ws + WS_WIN); const bf16_t* WOUT = (const bf16_t*)(ws + WS_WOUT);
    for (int l = 0; l < DEPTH; ++l) {
        hipLaunchKernelGGL(naive_gemm<EpiG1>, dim3(G1_N / 64, T / 64), dim3(256), 0, stream, XN, DM, WIN + (size_t)G1_ROW0 * DM, DM, DM, EpiG1{ws});
        hipLaunchKernelGGL(naive_gemm<EpiQ>, dim3(768 / 64, T / 64), dim3(256), 0, stream, (const bf16_t*)(ws + WS_R3 + R3_CQ), 256, (const bf16_t*)(ws + WS_WUQ) + (size_t)l * 768 * 256, 256, 256, EpiQ{ws});
        hipLaunchKernelGGL(naive_gemm<EpiKn>, dim3(512 / 64, T / 64), dim3(256), 0, stream, (const bf16_t*)(ws + WS_R3 + R3_CKV), 128, (const bf16_t*)(ws + WS_WUK) + (size_t)l * 512 * 128, 128, 128, EpiKn{ws});
        hipLaunchKernelGGL(naive_gemm<EpiVt>, dim3(T / 64, 512 / 64), dim3(256), 0, stream, (const bf16_t*)(ws + WS_WUV) + (size_t)l * 512 * 128, 128, (const bf16_t*)(ws + WS_R3 + R3_CKV), 128, 128, EpiVt{ws});
        hipLaunchKernelGGL(naive_krope, dim3(T * 16 / 256), dim3(256), 0, stream, ws);
        hipLaunchKernelGGL(naive_mem_attn, dim3(SEQ / 64, 8, NB), dim3(64), 0, stream, ws, l);
        hipLaunchKernelGGL(naive_mla_attn, dim3(SEQ / 64, 8, NB), dim3(64), 0, stream, ws);
        hipLaunchKernelGGL(naive_gemm<EpiG2>, dim3(G2_N / 64, T / 64), dim3(256), 0, stream, XN, DM, WIN + (size_t)G2_ROW0 * DM, DM, DM, EpiG2{ws});
        hipLaunchKernelGGL(naive_hgrn, dim3(16), dim3(512), 0, stream, ws, a.p.out_norm + l * 128, l);
        hipLaunchKernelGGL(naive_gemm<EpiOut>, dim3(DM / 64, T / 64), dim3(256), 0, stream, (const bf16_t*)(ws + WS_MIX), MIXW, WOUT, MIXW, MIXW, EpiOut{l == 0 ? a.p.x : a.p.out, a.p.out});
        a.phase = PH_LN; a.layer = l;
        hipLaunchKernelGGL(mk, dim3(G), dim3(NTHR), LDS_BYTES, stream, a);
    }
}
```

```cpp
#include <hip/hip_runtime.h>
#include <hip/hip_cooperative_groups.h>
#include <cstdio>
#include <cstdint>

#define GAS __attribute__((address_space(1)))
#define LAS __attribute__((address_space(3)))
typedef unsigned short bf16_t;
typedef unsigned v4u __attribute__((ext_vector_type(4)));
typedef unsigned v2u __attribute__((ext_vector_type(2)));
typedef float f32x4 __attribute__((ext_vector_type(4)));

constexpr int NB = 2, SEQ = 8192, T = NB * SEQ, DM = 1024, DEPTH = 2, MEML = 256;
constexpr int INW = 6048, MIXW = 2048, NWIN = 6144;
constexpr int G2_ROW0 = 0, G2_N = 4096, G1_ROW0 = 4096, G1_N = 2048;
constexpr int CHUNK = 64, NCH = SEQ / CHUNK;
constexpr float ALPHA = 1.4142135623730951f;
constexpr float RMS_EPS = 1e-6f, LN_EPS = 1e-5f;
constexpr float LOG2E = 1.4426950408889634f;
constexpr float C2_MLA = LOG2E * 0.10206207261596575f;
constexpr float C2_MEM = LOG2E * 0.08838834764831845f;

constexpr size_t MiB = 1u << 20;
constexpr size_t WS_CTL = 0, CTL_BYTES = 1 * MiB;
constexpr size_t WS_WIN = 1 * MiB;
constexpr size_t WS_WOUT = 13 * MiB;
constexpr size_t WS_WUQ = 17 * MiB;
constexpr size_t WS_WUK = 18 * MiB;
constexpr size_t WS_WUV = 18 * MiB + 512 * 1024;
constexpr size_t WS_KMEM = 19 * MiB;
constexpr size_t WS_VMEMT = 20 * MiB;
constexpr size_t WS_COS = 21 * MiB, WS_SIN = 22 * MiB;
constexpr size_t WS_SSQ_CQ = 23 * MiB, WS_SSQ_CKV = 23 * MiB + 256 * 1024;
constexpr size_t WS_LB = 23 * MiB + 512 * 1024;
constexpr size_t WS_DECAY = 24 * MiB;
constexpr size_t WS_XN = 25 * MiB;
constexpr size_t WS_MIX = 57 * MiB;
constexpr size_t WS_R1 = 121 * MiB;
constexpr size_t WS_R2 = 153 * MiB;
constexpr size_t WS_R3 = 217 * MiB;
constexpr size_t WS_END = 249 * MiB;
constexpr size_t R2_KN = 0, R2_VT = 16 * MiB, R2_KR = 32 * MiB;
constexpr size_t R3_CQ = 0, R3_CKV = 8 * MiB, R3_KRRAW = 12 * MiB, R3_MEMQ = 14 * MiB;

constexpr int NTHR = 512, NWAVES = 8;
__device__ __forceinline__ unsigned f2bf(float f) { unsigned u = __builtin_bit_cast(unsigned, f); return (u + 0x7fffu + ((u >> 16) & 1u)) >> 16; }
__device__ __forceinline__ float bf2f(unsigned short b) { return __builtin_bit_cast(float, (unsigned)b << 16); }
__device__ __forceinline__ unsigned pk2(float lo, float hi) { return f2bf(lo) | (f2bf(hi) << 16); }
__device__ __forceinline__ float silu_f(float v) { return v / (1.0f + __expf(-v)); }

template <int XM> __device__ __forceinline__ float shx(float v) { static_assert(XM >= 1 && XM < 32, "ds_swizzle xor within 32 lanes"); return __builtin_bit_cast(float, __builtin_amdgcn_ds_swizzle(__builtin_bit_cast(int, v), (XM << 10) | 0x1f)); }
__device__ __forceinline__ float xsum32(float v) { const unsigned u = __builtin_bit_cast(unsigned, v); auto r = __builtin_amdgcn_permlane32_swap(u, u, false, false); return __builtin_bit_cast(float, (unsigned)r[0]) + __builtin_bit_cast(float, (unsigned)r[1]); }
__device__ __forceinline__ float xmax32(float v) { const unsigned u = __builtin_bit_cast(unsigned, v); auto r = __builtin_amdgcn_permlane32_swap(u, u, false, false); return fmaxf(__builtin_bit_cast(float, (unsigned)r[0]), __builtin_bit_cast(float, (unsigned)r[1])); }

struct Ptrs {
    const float *x, *mem; const int* pos; const float *w_in, *lb_logits, *out_norm, *q_norm, *kv_norm, *w_uq, *w_uk, *w_uv, *w_mk, *w_mv, *w_out, *ln_g, *ln_b;
    float* out; unsigned char* ws;
};

__device__ __forceinline__ int cmap_win(int n) {
    if (n < 4480) return n;
    if (n < 4512) { const int i = n - 4480; return 4480 + ((i & 1) ? 16 + (i >> 1) : (i >> 1)); }
    if (n < 4608) return -1;
    return n - 96;
}
__device__ __forceinline__ int cmap_wuq(int n) {
    const int h = n / 96, j = n - h * 96;
    if (j < 64) return n;
    const int i = j - 64; return h * 96 + 64 + ((i & 1) ? 16 + (i >> 1) : (i >> 1));
}
__device__ __forceinline__ int cmap_id(int n) { return n; }
template <int MAPK>
__device__ __forceinline__ void transpose_item(const float* W, int K, int Nsrc, int Ndst, const float* kscale, bf16_t* WT, LAS float* scr, int item, int lane) {
    const int nblk = Ndst / 32, kb = item / nblk, nb = item % nblk, k0 = 64 * kb, n0 = 32 * nb;
    const int n = n0 + (lane & 31);
    const int c = MAPK == 0 ? cmap_id(n) : (MAPK == 1 ? cmap_win(n) : cmap_wuq(n));
#pragma unroll 8
    for (int i = 0; i < 32; ++i) { const int kk = 2 * i + (lane >> 5); float v = 0.f; if (c >= 0) { v = W[(size_t)(k0 + kk) * Nsrc + c]; if (kscale) v *= kscale[k0 + kk]; } scr[kk * 33 + (lane & 31)] = v; }
    asm volatile("s_waitcnt lgkmcnt(0)" ::: "memory");
    const int cc = lane & 7;
#pragma unroll
    for (int j = 0; j < 4; ++j) { const int nn = (lane >> 3) + 8 * j; const LAS float* s = scr + (8 * cc) * 33 + nn;
        v4u o; o.x = pk2(s[0 * 33], s[1 * 33]); o.y = pk2(s[2 * 33], s[3 * 33]); o.z = pk2(s[4 * 33], s[5 * 33]); o.w = pk2(s[6 * 33], s[7 * 33]);
        *(v4u*)(WT + (size_t)(n0 + nn) * K + k0 + 8 * cc) = o; }
    asm volatile("s_waitcnt lgkmcnt(0)" ::: "memory");
}

namespace pg8 {
#define PG8_LAS __attribute__((address_space(3)))
typedef unsigned short bf16_t;
typedef short bf16x8 __attribute__((ext_vector_type(8)));
typedef float f32x4 __attribute__((ext_vector_type(4)));
typedef unsigned u32x4 __attribute__((ext_vector_type(4)));
constexpr int BM = 256, BK = 64, HALF = 128, HTB = HALF * BK * 2  , STAGE_BYTES = 8 * HTB, NXCD = 8, WGM = 8;

__host__ __device__ __forceinline__ int lds_byte(int r, int c) { const int st = (r >> 4) * 2 + (c >> 5), rr = r & 15, cc = c & 31, ob = rr * 64 + cc * 2; return st * 1024 + (ob ^ (((ob >> 9) & 1) << 5)); }
__host__ __device__ __forceinline__ void stage_rc(int b, int& R, int& C) { const int st = b / 1024, sb = b % 1024, swz = sb ^ (((sb >> 9) & 1) << 5); R = (st >> 1) * 16 + swz / 64; C = (st & 1) * 32 + (swz % 64) / 2; }
__host__ __device__ __forceinline__ int perm32(int rho) { const int n = rho >> 4, i = rho & 15; return 8 * (i >> 2) + 4 * n + (i & 3); }

struct Unit { int pm, pn; };
struct Gemm { const bf16_t* A; const bf16_t* Bt; int M, N, K, lda, ldb; };

struct StaticOrder {
    int nM, nN, nwg, G, c;
    __host__ __device__ void init(int M, int N, int G_, int c_) { nM = M / BM; nN = N / BM; nwg = nM * nN; G = G_; c = c_; }
    __host__ __device__ bool next(int i, Unit& u) const {
        const long L = (long)i * G + c; if (L >= nwg) return false;
        int wgid = (int)L; { const int q = nwg / NXCD, r = nwg % NXCD, xcd = wgid % NXCD, off = wgid / NXCD; wgid = (xcd < r ? xcd * (q + 1) : r * (q + 1) + (xcd - r) * q) + off; }
        const int nig = WGM * nN, gid = wgid / nig, fm = gid * WGM, gsz = (nM - fm) < WGM ? (nM - fm) : WGM;
        u.pm = fm + ((wgid % nig) % gsz); u.pn = (wgid % nig) / gsz; return true;
    }
    __device__ __forceinline__ void a_ready(const Unit&) const {}
    __device__ __forceinline__ void done(const Unit&) const {}
};

__device__ __forceinline__ unsigned cvt_pk_bf16(float lo, float hi) { unsigned r; asm volatile("v_cvt_pk_bf16_f32 %0, %1, %2" : "=v"(r) : "v"(lo), "v"(hi)); return r; }
template <class Epi, class Sched, bool ALIGN_EPI = false, bool SP2 = false>
__device__ __forceinline__ void gemm_phase(PG8_LAS unsigned char* lds, const Gemm g, const Sched& S, const Epi& E, const int wave_id  ) {
    int lane_; asm volatile("v_mbcnt_lo_u32_b32 %0, -1, 0\n\tv_mbcnt_hi_u32_b32 %0, -1, %0" : "=v"(lane_));
    const int wid = wave_id, lane = lane_, tid = wid * 64 + lane, wr = wid >> 2, wc = wid & 3, fr = lane & 15, fq = lane >> 4;
    const int K = g.K, nt = K / BK;
    unsigned voffA[2], voffB[2];
#pragma unroll
    for (int i = 0; i < 2; ++i) { int R, C; stage_rc(tid * 16 + i * 8192, R, C); const int Rb = Epi::PERM ? ((R & ~31) + perm32(R & 31)) : R;
        voffA[i] = (unsigned)(R * K + C) * 2u; voffB[i] = (unsigned)(Rb * K + C) * 2u; }
    const size_t kstep = (size_t)(BK * 2);
    const size_t hstepA = (size_t)HALF * K * 2;
#define hstepB hstepA
    const size_t tstepA = 2 * hstepA;
#define tstepB tstepA
    const unsigned ldsw = (unsigned)wid * 1024u;
    const int aoff = lds_byte(wr * 64 + fr, fq * 8), boff = lds_byte(wc * 32 + fr, fq * 8);
#define PG8_SA(b, h) (((b) * 2 + (h)) * HTB)
#define PG8_SB(b, h) ((4 + (b) * 2 + (h)) * HTB)
#define PG8_STAGE(bufoff, gbase, voff) do { _Pragma("unroll") for (int _i = 0; _i < 2; ++_i) \
        __builtin_amdgcn_global_load_lds((const unsigned*)((const char*)(gbase) + (voff)[_i]), (PG8_LAS unsigned*)(lds + (bufoff) + ldsw + _i * 8192), 16, 0, 0); } while (0)
#define PG8_LDA(dst, b, h) do { _Pragma("unroll") for (int m = 0; m < 4; ++m) _Pragma("unroll") for (int k = 0; k < 2; ++k) dst[m][k] = *(const PG8_LAS bf16x8*)(lds + PG8_SA(b, h) + aoff + m * 2048 + k * 1024); } while (0)
#define PG8_LDB(dst, b, h) do { _Pragma("unroll") for (int n = 0; n < 2; ++n) _Pragma("unroll") for (int k = 0; k < 2; ++k) dst[n][k] = *(const PG8_LAS bf16x8*)(lds + PG8_SB(b, h) + boff + n * 2048 + k * 1024); } while (0)
#define PG8_MMA(ai, bj, At, Bt) do { __builtin_amdgcn_s_setprio(1); _Pragma("unroll") for (int m = 0; m < 4; ++m) _Pragma("unroll") for (int n = 0; n < 2; ++n) _Pragma("unroll") for (int k = 0; k < 2; ++k) \
        acc[ai][bj][m][n] = __builtin_amdgcn_mfma_f32_16x16x32_bf16(Bt[n][k], At[m][k], acc[ai][bj][m][n], 0, 0, 0); __builtin_amdgcn_s_setprio(0); } while (0)
#define PG8_WAIT_V(n) asm volatile("s_waitcnt vmcnt(" #n ")" ::: "memory")
#define PG8_WAIT_L(n) asm volatile("s_waitcnt lgkmcnt(" #n ")" ::: "memory")
#define PG8_BAR __builtin_amdgcn_s_barrier()
#define PG8_SCHED __builtin_amdgcn_sched_barrier(0)
    Unit cur, nxt; int ui = 0;
    if (!S.next(0, cur)) return;
    f32x4 acc[2][2][4][2];
#pragma unroll
    for (int a = 0; a < 2; ++a)
#pragma unroll
        for (int b = 0; b < 2; ++b)
#pragma unroll
            for (int m = 0; m < 4; ++m)
#pragma unroll
                for (int n = 0; n < 2; ++n) acc[a][b][m][n] = (f32x4){0.f, 0.f, 0.f, 0.f};
    bf16x8 At[4][2], B0[2][2], B1[2][2];
    const char* cA = (const char*)g.A + (size_t)cur.pm * tstepA; const char* cB = (const char*)g.Bt + (size_t)cur.pn * tstepB;
    S.a_ready(cur);
    if constexpr (SP2) {
        PG8_STAGE(PG8_SB(0, 0), cB, voffB); PG8_STAGE(PG8_SB(0, 1), cB + hstepB, voffB); PG8_STAGE(PG8_SA(0, 0), cA, voffA); PG8_STAGE(PG8_SA(0, 1), cA + hstepA, voffA);
        if (wr == 1) PG8_BAR;
        PG8_WAIT_V(2); PG8_BAR;
        PG8_STAGE(PG8_SB(1, 0), cB + kstep, voffB); PG8_STAGE(PG8_SA(1, 0), cA + kstep, voffA); PG8_STAGE(PG8_SB(1, 1), cB + hstepB + kstep, voffB);
        PG8_WAIT_V(6); PG8_BAR;
    } else {
        PG8_STAGE(PG8_SB(0, 0), cB, voffB); PG8_STAGE(PG8_SA(0, 0), cA, voffA); PG8_STAGE(PG8_SB(0, 1), cB + hstepB, voffB); PG8_STAGE(PG8_SA(0, 1), cA + hstepA, voffA);
        if (wr == 1) PG8_BAR;
        PG8_WAIT_V(4); PG8_BAR;
        PG8_STAGE(PG8_SB(1, 0), cB + kstep, voffB); PG8_STAGE(PG8_SA(1, 0), cA + kstep, voffA); PG8_STAGE(PG8_SB(1, 1), cB + hstepB + kstep, voffB);
        PG8_WAIT_V(6); PG8_BAR;
    }
    for (;;) {
        const bool has_next = S.next(ui + 1, nxt);
        const char* nA = has_next ? (const char*)g.A + (size_t)nxt.pm * tstepA : cA; const char* nB = has_next ? (const char*)g.Bt + (size_t)nxt.pn * tstepB : cB;
        for (int t = 0; t < nt; t += 2) {
            const bool last = (t == nt - 2);
            const char* a1 = cA + (size_t)(t + 1) * kstep;
            const char* a2 = last ? nA : cA + (size_t)(t + 2) * kstep; const char* b2 = last ? nB : cB + (size_t)(t + 2) * kstep;
            const char* a3 = a2 + kstep; const char* b3 = b2 + kstep;
            if (last && has_next) S.a_ready(nxt);
            if constexpr (SP2) {
            PG8_LDB(B0, 0, 0); PG8_LDB(B1, 0, 1); PG8_SCHED; PG8_LDA(At, 0, 0); PG8_STAGE(PG8_SA(1, 1), a1 + hstepA, voffA);
            PG8_WAIT_V(8); PG8_WAIT_L(0); PG8_BAR; PG8_MMA(0, 0, At, B0); PG8_MMA(0, 1, At, B1); PG8_BAR; PG8_SCHED;
            PG8_LDA(At, 0, 1); PG8_STAGE(PG8_SB(0, 0), b2, voffB); PG8_STAGE(PG8_SB(0, 1), b2 + hstepB, voffB); PG8_STAGE(PG8_SA(0, 0), a2, voffA);
            PG8_WAIT_V(8); PG8_WAIT_L(0); PG8_BAR; PG8_MMA(1, 0, At, B0); PG8_MMA(1, 1, At, B1); PG8_BAR; PG8_SCHED;
            PG8_LDB(B0, 1, 0); PG8_LDB(B1, 1, 1); PG8_SCHED; PG8_LDA(At, 1, 0); PG8_STAGE(PG8_SA(0, 1), a2 + hstepA, voffA);
            PG8_WAIT_V(8); PG8_WAIT_L(0); PG8_BAR; PG8_MMA(0, 0, At, B0); PG8_MMA(0, 1, At, B1); PG8_BAR; PG8_SCHED;
            PG8_LDA(At, 1, 1); PG8_STAGE(PG8_SB(1, 0), b3, voffB); PG8_STAGE(PG8_SB(1, 1), b3 + hstepB, voffB); PG8_STAGE(PG8_SA(1, 0), a3, voffA);
            PG8_WAIT_V(8); PG8_WAIT_L(0); PG8_BAR; PG8_MMA(1, 0, At, B0); PG8_MMA(1, 1, At, B1); PG8_BAR; PG8_SCHED;
            } else {
            PG8_LDB(B0, 0, 0); PG8_SCHED; PG8_LDA(At, 0, 0); PG8_STAGE(PG8_SA(1, 1), a1 + hstepA, voffA);
            PG8_WAIT_L(8); PG8_BAR; PG8_WAIT_L(0); PG8_MMA(0, 0, At, B0); PG8_BAR; PG8_SCHED;
            PG8_LDB(B1, 0, 1); PG8_STAGE(PG8_SB(0, 0), b2, voffB);
            PG8_BAR; PG8_WAIT_L(0); PG8_MMA(0, 1, At, B1); PG8_BAR;
            PG8_LDA(At, 0, 1); PG8_STAGE(PG8_SA(0, 0), a2, voffA);
            PG8_BAR; PG8_WAIT_L(0); PG8_MMA(1, 0, At, B0); PG8_BAR; PG8_SCHED;
            PG8_STAGE(PG8_SB(0, 1), b2 + hstepB, voffB);
            PG8_WAIT_V(6); PG8_BAR; PG8_MMA(1, 1, At, B1); PG8_BAR;
            PG8_LDB(B0, 1, 0); PG8_SCHED; PG8_LDA(At, 1, 0); PG8_STAGE(PG8_SA(0, 1), a2 + hstepA, voffA);
            PG8_WAIT_L(8); PG8_BAR; PG8_WAIT_L(0); PG8_MMA(0, 0, At, B0); PG8_BAR; PG8_SCHED;
            PG8_LDB(B1, 1, 1); PG8_STAGE(PG8_SB(1, 0), b3, voffB);
            PG8_BAR; PG8_WAIT_L(0); PG8_MMA(0, 1, At, B1); PG8_BAR;
            PG8_LDA(At, 1, 1); PG8_STAGE(PG8_SA(1, 0), a3, voffA);
            PG8_BAR; PG8_WAIT_L(0); PG8_MMA(1, 0, At, B0); PG8_BAR; PG8_SCHED;
            PG8_STAGE(PG8_SB(1, 1), b3 + hstepB, voffB);
            PG8_WAIT_V(6); PG8_BAR; PG8_MMA(1, 1, At, B1); PG8_BAR;
            }
        }
        if constexpr (ALIGN_EPI) { if (wr == 0) PG8_BAR; }
        if constexpr (!Epi::AFTER_DRAIN) { E(acc, cur, wr, wc, fr, fq); S.done(cur); }
        if (!has_next) break;
#pragma unroll
        for (int a = 0; a < 2; ++a)
#pragma unroll
            for (int b = 0; b < 2; ++b)
#pragma unroll
                for (int m = 0; m < 4; ++m)
#pragma unroll
                    for (int n = 0; n < 2; ++n) acc[a][b][m][n] = (f32x4){0.f, 0.f, 0.f, 0.f};
        cur = nxt; cA = nA; cB = nB; ++ui;
        if constexpr (ALIGN_EPI) { if (wr == 1) PG8_BAR; }
    }
    PG8_WAIT_V(0);
    if constexpr (!ALIGN_EPI) { if (wr == 0) PG8_BAR; }
    PG8_BAR;
    if constexpr (Epi::AFTER_DRAIN) { E.fused(acc, cur, wr, wc, fr, fq, lds, wid, lane); S.done(cur); }
#undef hstepB
#undef tstepB
#undef PG8_SA
#undef PG8_SB
#undef PG8_STAGE
#undef PG8_LDA
#undef PG8_LDB
#undef PG8_MMA
#undef PG8_WAIT_V
#undef PG8_WAIT_L
#undef PG8_BAR
#undef PG8_SCHED
}
}

namespace pg8 {
__device__ __forceinline__ float silu_fast(float v) { return v * __builtin_amdgcn_rcpf(1.0f + __builtin_amdgcn_exp2f(-1.4426950408889634f * v)); }
__device__ __forceinline__ u32x4 pack8(const f32x4 a, const f32x4 b) { u32x4 w; w.x = cvt_pk_bf16(a[0], a[1]); w.y = cvt_pk_bf16(a[2], a[3]); w.z = cvt_pk_bf16(b[0], b[1]); w.w = cvt_pk_bf16(b[2], b[3]); return w; }
__device__ __forceinline__ f32x4 silu4(const f32x4 a) { return (f32x4){silu_fast(a[0]), silu_fast(a[1]), silu_fast(a[2]), silu_fast(a[3])}; }
__device__ __forceinline__ float sq4(const f32x4 a) { return (a[0] * a[0] + a[1] * a[1]) + (a[2] * a[2] + a[3] * a[3]); }
#define EPI_ROWS_BEGIN _Pragma("unroll") for (int ai = 0; ai < 2; ++ai) _Pragma("unroll") for (int m = 0; m < 4; ++m) { const int row = u.pm * BM + ai * HALF + wr * 64 + m * 16 + fr;
#define EPI_ROWS_END asm volatile("" ::: "memory"); }

struct EpiG1v {
    static constexpr bool PERM = true, AFTER_DRAIN = false; unsigned char* ws;
    __device__ __forceinline__ void operator()(const f32x4 (&acc)[2][2][4][2], const Unit& u, int wr, int wc, int fr, int fq) const {
        const int pn = u.pn, ct = wc * 32 + 8 * fq;
        if (pn == 0) {
            EPI_ROWS_BEGIN
                bf16_t* o = (bf16_t*)(ws + WS_R3 + R3_CQ) + (size_t)row * 256 + ct;
                *(u32x4*)o = pack8(acc[ai][0][m][0], acc[ai][0][m][1]); *(u32x4*)(o + HALF) = pack8(acc[ai][1][m][0], acc[ai][1][m][1]);
                float s = (sq4(acc[ai][0][m][0]) + sq4(acc[ai][0][m][1])) + (sq4(acc[ai][1][m][0]) + sq4(acc[ai][1][m][1]));
                s += shx<16>(s); s = xsum32(s);
                if (fq == 0) ((float*)(ws + WS_SSQ_CQ))[(size_t)row * 4 + wc] = s;
            EPI_ROWS_END
        } else if (pn == 1) {
            EPI_ROWS_BEGIN
                *(u32x4*)((bf16_t*)(ws + WS_R3 + R3_CKV) + (size_t)row * 128 + ct) = pack8(acc[ai][0][m][0], acc[ai][0][m][1]);
                float s = sq4(acc[ai][0][m][0]) + sq4(acc[ai][0][m][1]);
                s += shx<16>(s); s = xsum32(s);
                if (fq == 0) ((float*)(ws + WS_SSQ_CKV))[(size_t)row * 4 + wc] = s;
                if (wc == 0) { float* kr = (float*)(ws + WS_R3 + R3_KRRAW) + (size_t)row * 32 + ct; *(f32x4*)kr = acc[ai][1][m][0]; *(f32x4*)(kr + 4) = acc[ai][1][m][1]; }
            EPI_ROWS_END
        } else if (pn == 4 || pn == 5) {
            EPI_ROWS_BEGIN
                bf16_t* o = (bf16_t*)(ws + WS_R3 + R3_MEMQ) + (size_t)row * 512 + (pn - 4) * 256 + ct;
                *(u32x4*)o = pack8(acc[ai][0][m][0] * C2_MEM, acc[ai][0][m][1] * C2_MEM); *(u32x4*)(o + HALF) = pack8(acc[ai][1][m][0] * C2_MEM, acc[ai][1][m][1] * C2_MEM);
            EPI_ROWS_END
        } else {
            const int mc = (pn < 4 ? 1024 + (pn - 2) * 256 : 1536 + (pn - 6) * 256) + ct;
            EPI_ROWS_BEGIN
                bf16_t* o = (bf16_t*)(ws + WS_MIX) + (size_t)row * MIXW + mc;
                *(u32x4*)o = pack8(silu4(acc[ai][0][m][0]), silu4(acc[ai][0][m][1])); *(u32x4*)(o + HALF) = pack8(silu4(acc[ai][1][m][0]), silu4(acc[ai][1][m][1]));
            EPI_ROWS_END
        }
    }
};
struct EpiG2v {
    static constexpr bool PERM = true, AFTER_DRAIN = false; unsigned char* ws;
    __device__ __forceinline__ void operator()(const f32x4 (&acc)[2][2][4][2], const Unit& u, int wr, int wc, int fr, int fq) const {
        const int seg = u.pn >> 2, c0 = (u.pn & 3) * 256 + wc * 32 + 8 * fq;
        if (seg == 1) {
            EPI_ROWS_BEGIN
                float* o = (float*)(ws + WS_R2) + (size_t)row * 1024 + c0;
                *(f32x4*)o = acc[ai][0][m][0]; *(f32x4*)(o + 4) = acc[ai][0][m][1]; *(f32x4*)(o + HALF) = acc[ai][1][m][0]; *(f32x4*)(o + HALF + 4) = acc[ai][1][m][1];
            EPI_ROWS_END
        } else if (seg == 3) {
            EPI_ROWS_BEGIN
                bf16_t* o = (bf16_t*)(ws + WS_MIX) + (size_t)row * MIXW + c0;
                *(u32x4*)o = pack8(silu4(acc[ai][0][m][0]), silu4(acc[ai][0][m][1])); *(u32x4*)(o + HALF) = pack8(silu4(acc[ai][1][m][0]), silu4(acc[ai][1][m][1]));
            EPI_ROWS_END
        } else {
            bf16_t* base = (bf16_t*)(ws + (seg == 0 ? WS_R1 : WS_R3));
            EPI_ROWS_BEGIN
                bf16_t* o = base + (size_t)row * 1024 + c0;
                *(u32x4*)o = pack8(acc[ai][0][m][0], acc[ai][0][m][1]); *(u32x4*)(o + HALF) = pack8(acc[ai][1][m][0], acc[ai][1][m][1]);
            EPI_ROWS_END
        }
    }
};
__device__ __forceinline__ float rstd_of(const float* ssq4, float n) { const f32x4 q = *(const f32x4*)ssq4; return 1.0f / sqrtf(((q[0] + q[1]) + (q[2] + q[3])) * (1.0f / n) + RMS_EPS); }
struct EpiQv {
    static constexpr bool PERM = true, AFTER_DRAIN = false; unsigned char* ws;
    __device__ __forceinline__ void operator()(const f32x4 (&acc)[2][2][4][2], const Unit& u, int wr, int wc, int fr, int fq) const {
        EPI_ROWS_BEGIN
            const float r = rstd_of((const float*)(ws + WS_SSQ_CQ) + (size_t)row * 4, 256.f) * C2_MLA;
#pragma unroll
            for (int bj = 0; bj < 2; ++bj) {
                const int col = u.pn * BM + bj * HALF + wc * 32 + 8 * fq; const int h = col / 96, j = col - h * 96;
                f32x4 a = acc[ai][bj][m][0] * r, b = acc[ai][bj][m][1] * r;
                if (j >= 64) {
                    const int i0 = (j - 64) >> 1;
                    const f32x4 cs = *(const f32x4*)((const float*)(ws + WS_COS) + (size_t)row * 16 + i0), sn = *(const f32x4*)((const float*)(ws + WS_SIN) + (size_t)row * 16 + i0);
                    const f32x4 a2 = (f32x4){a[0] * cs[0] - a[1] * sn[0], a[0] * sn[0] + a[1] * cs[0], a[2] * cs[1] - a[3] * sn[1], a[2] * sn[1] + a[3] * cs[1]};
                    const f32x4 b2 = (f32x4){b[0] * cs[2] - b[1] * sn[2], b[0] * sn[2] + b[1] * cs[2], b[2] * cs[3] - b[3] * sn[3], b[2] * sn[3] + b[3] * cs[3]};
                    a = a2; b = b2;
                }
                *(u32x4*)((bf16_t*)(ws + WS_R1) + (size_t)row * 768 + col) = pack8(a, b);
            }
        EPI_ROWS_END
    }
};
struct EpiKnv {
    static constexpr bool PERM = true, AFTER_DRAIN = false; unsigned char* ws;
    __device__ __forceinline__ void operator()(const f32x4 (&acc)[2][2][4][2], const Unit& u, int wr, int wc, int fr, int fq) const {
        EPI_ROWS_BEGIN
            const float r = rstd_of((const float*)(ws + WS_SSQ_CKV) + (size_t)row * 4, 128.f);
            bf16_t* o = (bf16_t*)(ws + WS_R2 + R2_KN) + (size_t)row * 512 + u.pn * BM + wc * 32 + 8 * fq;
            *(u32x4*)o = pack8(acc[ai][0][m][0] * r, acc[ai][0][m][1] * r); *(u32x4*)(o + HALF) = pack8(acc[ai][1][m][0] * r, acc[ai][1][m][1] * r);
        EPI_ROWS_END
    }
};
struct EpiVtv {
    static constexpr bool PERM = true, AFTER_DRAIN = false; unsigned char* ws;
    __device__ __forceinline__ void operator()(const f32x4 (&acc)[2][2][4][2], const Unit& u, int wr, int wc, int fr, int fq) const {
#pragma unroll
        for (int bj = 0; bj < 2; ++bj) {
            const int tok = u.pn * BM + bj * HALF + wc * 32 + 8 * fq; f32x4 r0, r1;
#pragma unroll
            for (int i = 0; i < 4; ++i) { r0[i] = rstd_of((const float*)(ws + WS_SSQ_CKV) + (size_t)(tok + i) * 4, 128.f); r1[i] = rstd_of((const float*)(ws + WS_SSQ_CKV) + (size_t)(tok + 4 + i) * 4, 128.f); }
            const int b = tok >> 13, s = tok & (SEQ - 1);
            EPI_ROWS_BEGIN
                *(u32x4*)((bf16_t*)(ws + WS_R2 + R2_VT) + (size_t)(b * 512 + row) * SEQ + s) = pack8(acc[ai][bj][m][0] * r0, acc[ai][bj][m][1] * r1);
            EPI_ROWS_END
        }
    }
};
struct EpiOutv {
    static constexpr bool PERM = true, AFTER_DRAIN = false; const float* xres; float* out;
    __device__ __forceinline__ void operator()(const f32x4 (&acc)[2][2][4][2], const Unit& u, int wr, int wc, int fr, int fq) const {
        EPI_ROWS_BEGIN
#pragma unroll
            for (int bj = 0; bj < 2; ++bj) {
                const size_t off = (size_t)row * DM + u.pn * BM + bj * HALF + wc * 32 + 8 * fq;
                const f32x4 x0 = *(const f32x4*)(xres + off), x1 = *(const f32x4*)(xres + off + 4);
                *(f32x4*)(out + off) = x0 * ALPHA + acc[ai][bj][m][0]; *(f32x4*)(out + off + 4) = x1 * ALPHA + acc[ai][bj][m][1];
            }
        EPI_ROWS_END
    }
};
}


namespace att {
typedef short bf16x8 __attribute__((ext_vector_type(8)));
typedef float f32x16 __attribute__((ext_vector_type(16)));
typedef float f32x2_t __attribute__((ext_vector_type(2))); typedef __bf16 bf16x2_t __attribute__((ext_vector_type(2)));
__device__ __forceinline__ unsigned cvtpk(float lo, float hi) { f32x2_t v = {lo, hi}; bf16x2_t b = __builtin_convertvector(v, bf16x2_t); return __builtin_bit_cast(unsigned, b); }
__device__ __forceinline__ int lane_fresh() { int l; asm volatile("v_mbcnt_lo_u32_b32 %0, -1, 0\n\tv_mbcnt_hi_u32_b32 %0, -1, %0" : "=v"(l)); return l; }
#define MFMA32(a, b, c) __builtin_amdgcn_mfma_f32_32x32x16_bf16((a), (b), (c), 0, 0, 0)

template <bool MLA> struct Cfg;
template <> struct Cfg<true>  { static constexpr int DQK = 96,  DV = 64,  KP = 208, VP = 144, NKL = 2, NVL = 1; };
template <> struct Cfg<false> { static constexpr int DQK = 128, DV = 128, KP = 272, VP = 144, NKL = 2, NVL = 2; };
template <bool MLA> struct Buf { static constexpr int KB = 64 * Cfg<MLA>::KP, VB = Cfg<MLA>::DV * Cfg<MLA>::VP, SZ = KB + VB; };

template <bool MLA>
__device__ __forceinline__ void attn_unit(LAS unsigned char* lds, unsigned char* ws, int l, int b, int h, int qb, int wave) {
    typedef Cfg<MLA> C; typedef Buf<MLA> B;
    constexpr int NC = C::DQK / 16, NE = C::DV / 32;
    const int lane = lane_fresh(), tid = wave * 64 + lane, a = lane & 31, hh = lane >> 5;
    const int q0 = qb * 256, qrow = q0 + wave * 32 + a;
    const size_t grow = (size_t)b * SEQ + qrow;
    const int NT = MLA ? 4 * (qb + 1) : 4;
    const bf16_t *ks0, *ks1, *vs0, *vs1; size_t kstep, vstep; int kd0, kd1, vd0, vd1; bool k1on = true;
    if (MLA) {
        const bf16_t* KN = (const bf16_t*)(ws + WS_R2 + R2_KN); const bf16_t* KR = (const bf16_t*)(ws + WS_R2 + R2_KR); const bf16_t* VT = (const bf16_t*)(ws + WS_R2 + R2_VT);
        ks0 = KN + ((size_t)b * SEQ + (tid >> 3)) * 512 + h * 64 + (tid & 7) * 8; kd0 = (tid >> 3) * C::KP + (tid & 7) * 16;
        ks1 = KR + ((size_t)b * SEQ + ((tid & 255) >> 2)) * 32 + (tid & 3) * 8; kd1 = ((tid & 255) >> 2) * C::KP + 128 + (tid & 3) * 16; k1on = tid < 256;
        kstep = (size_t)64 * 512; vs1 = nullptr; vd1 = 0;
        vs0 = VT + ((size_t)(b * 512 + h * 64) + (tid >> 3)) * SEQ + (tid & 7) * 8; vd0 = (tid >> 3) * C::VP + (tid & 7) * 16; vstep = 64;
    } else {
        const bf16_t* KM = (const bf16_t*)(ws + WS_KMEM) + (size_t)((l * 2 + b) * 4 + h) * 256 * 128; const bf16_t* VM = (const bf16_t*)(ws + WS_VMEMT) + (size_t)((l * 2 + b) * 4 + h) * 128 * 256;
        ks0 = KM + (size_t)(tid >> 4) * 128 + (tid & 15) * 8; kd0 = (tid >> 4) * C::KP + (tid & 15) * 16;
        ks1 = ks0 + 32 * 128; kd1 = kd0 + 32 * C::KP; kstep = (size_t)64 * 128;
        vs0 = VM + (size_t)(tid >> 3) * 256 + (tid & 7) * 8; vd0 = (tid >> 3) * C::VP + (tid & 7) * 16;
        vs1 = vs0 + 64 * 256; vd1 = vd0 + 64 * C::VP; vstep = 64;
    }
    const size_t kstep1 = MLA ? (size_t)64 * 32 : kstep;
    const bf16_t* qp = MLA ? (const bf16_t*)(ws + WS_R1) + grow * 768 + h * 96 + 8 * hh : (const bf16_t*)(ws + WS_R3 + R3_MEMQ) + grow * 512 + h * 128 + 8 * hh;
    bf16x8 qf[NC];
#pragma unroll
    for (int c = 0; c < NC; ++c) qf[c] = *(const bf16x8*)(qp + 16 * c);
    const int pa = (a & 0x13) | ((a & 4) << 1) | ((a & 8) >> 1);
    const int koff = pa * C::KP + 16 * hh, voff = B::KB + a * C::VP + 16 * hh;
    f32x16 o[NE];
#pragma unroll
    for (int e = 0; e < NE; ++e)
#pragma unroll
        for (int r = 0; r < 16; ++r) o[e][r] = 0.f;
    float m_run = -1e30f, l_run = 0.f;
    v4u rk0, rk1, rv0, rv1;
    rk0 = *(const v4u*)ks0; rk1 = (v4u){0u, 0u, 0u, 0u}; if (k1on) rk1 = *(const v4u*)ks1; rv0 = *(const v4u*)vs0; if (!MLA) rv1 = *(const v4u*)vs1;
    *(LAS v4u*)(lds + kd0) = rk0; if (k1on) *(LAS v4u*)(lds + kd1) = rk1; *(LAS v4u*)(lds + B::KB + vd0) = rv0; if (!MLA) *(LAS v4u*)(lds + B::KB + vd1) = rv1;
    __syncthreads();
    for (int t = 0; t < NT; ++t) {
        const bool more = t + 1 < NT;
        if (more) { rk0 = *(const v4u*)(ks0 + (size_t)(t + 1) * kstep); if (k1on) rk1 = *(const v4u*)(ks1 + (size_t)(t + 1) * kstep1); rv0 = *(const v4u*)(vs0 + (size_t)(t + 1) * vstep); if (!MLA) rv1 = *(const v4u*)(vs1 + (size_t)(t + 1) * vstep); }
        LAS unsigned char* bufp = lds + (t & 1) * B::SZ;
        const int kv0 = 64 * t;
        const bool skip = MLA && (kv0 > q0 + wave * 32 + 31);
        if (!skip) {
            f32x16 p[2];
#pragma unroll
            for (int i = 0; i < 2; ++i) {
#pragma unroll
                for (int r = 0; r < 16; ++r) p[i][r] = 0.f;
#pragma unroll
                for (int c = 0; c < NC; ++c) { const bf16x8 kf = *(const LAS bf16x8*)(bufp + koff + i * 32 * C::KP + 32 * c); p[i] = MFMA32(kf, qf[c], p[i]); }
            }
            if (MLA && (kv0 + 63 > q0 + wave * 32)) {
#pragma unroll
                for (int i = 0; i < 2; ++i)
#pragma unroll
                    for (int r = 0; r < 16; ++r) { const int kv = kv0 + 32 * i + 16 * (r >> 3) + 8 * hh + (r & 7); if (kv > qrow) p[i][r] = -1e30f; }
            }
            float mx = p[0][0];
#pragma unroll
            for (int r = 1; r < 16; ++r) mx = fmaxf(mx, p[0][r]);
#pragma unroll
            for (int r = 0; r < 16; ++r) mx = fmaxf(mx, p[1][r]);
            mx = xmax32(mx);
            const float m_new = fmaxf(m_run, mx);
            if (__any(m_new > m_run)) {
                const float al = __builtin_amdgcn_exp2f(m_run - m_new);
                l_run *= al;
#pragma unroll
                for (int e = 0; e < NE; ++e)
#pragma unroll
                    for (int r = 0; r < 16; ++r) o[e][r] *= al;
                m_run = m_new;
            }
            float ls = 0.f;
#pragma unroll
            for (int i = 0; i < 2; ++i)
#pragma unroll
                for (int r = 0; r < 16; ++r) { p[i][r] = __builtin_amdgcn_exp2f(p[i][r] - m_run); ls += p[i][r]; }
            l_run += ls;
            bf16x8 pf[4];
#pragma unroll
            for (int s = 0; s < 4; ++s) {
                v4u w; const int i = s >> 1, r0 = 8 * (s & 1);
                w.x = cvtpk(p[i][r0], p[i][r0 + 1]); w.y = cvtpk(p[i][r0 + 2], p[i][r0 + 3]); w.z = cvtpk(p[i][r0 + 4], p[i][r0 + 5]); w.w = cvtpk(p[i][r0 + 6], p[i][r0 + 7]);
                pf[s] = __builtin_bit_cast(bf16x8, w);
            }
#pragma unroll
            for (int e = 0; e < NE; ++e)
#pragma unroll
                for (int s = 0; s < 4; ++s) { const bf16x8 vf = *(const LAS bf16x8*)(bufp + voff + e * 32 * C::VP + 32 * s); o[e] = MFMA32(vf, pf[s], o[e]); }
        }
        if (more) {
            LAS unsigned char* nb = lds + ((t + 1) & 1) * B::SZ;
            *(LAS v4u*)(nb + kd0) = rk0; if (k1on) *(LAS v4u*)(nb + kd1) = rk1; *(LAS v4u*)(nb + B::KB + vd0) = rv0; if (!MLA) *(LAS v4u*)(nb + B::KB + vd1) = rv1;
        }
        __syncthreads();
    }
    const float inv = 1.0f / xsum32(l_run);
    bf16_t* mix = (bf16_t*)(ws + WS_MIX) + grow * MIXW + (MLA ? 1024 + h * 64 : 1536 + h * 128) + 4 * hh;
#pragma unroll
    for (int e = 0; e < NE; ++e)
#pragma unroll
        for (int g = 0; g < 4; ++g) {
            v2u* pp = (v2u*)(mix + 32 * e + 8 * g); const v2u gt = *pp;
            const float g0 = bf2f(gt.x & 0xffff), g1 = bf2f(gt.x >> 16), g2 = bf2f(gt.y & 0xffff), g3 = bf2f(gt.y >> 16);
            *pp = (v2u){cvtpk(o[e][4 * g] * inv * g0, o[e][4 * g + 1] * inv * g1), cvtpk(o[e][4 * g + 2] * inv * g2, o[e][4 * g + 3] * inv * g3)};
        }
}
__device__ __forceinline__ void mla_phase(LAS unsigned char* lds, unsigned char* ws, int wave) {
    for (int p = blockIdx.x; p < 256; p += gridDim.x) { const int bh = p >> 4, j = p & 15;
        attn_unit<true>(lds, ws, 0, bh >> 3, bh & 7, 31 - j, wave); attn_unit<true>(lds, ws, 0, bh >> 3, bh & 7, j, wave); }
}
__device__ __forceinline__ void mem_phase(LAS unsigned char* lds, unsigned char* ws, int l, int wave) {
    for (int u = blockIdx.x; u < 256; u += gridDim.x) attn_unit<false>(lds, ws, l, u >> 7, (u >> 5) & 3, u & 31, wave);
}
}


namespace hg {
using att::bf16x8; using att::f32x16; using att::cvtpk; using att::lane_fresh;
typedef unsigned long long u64;
constexpr int P272 = 272, P144 = 144;
constexpr int L_KT = 0, L_QT = 64 * P272, L_KH = 2 * 64 * P272, L_VT = L_KH + 128 * P144, L_QS = L_VT + 128 * P144, H1_LDS = L_QS + 4 * 128 * 4;
__device__ __forceinline__ size_t st_off(int T0, int h, int e) { return (size_t)(T0 + (e >> 1)) * 4096 + 512 * h + 256 * (e & 1); }

__device__ __forceinline__ void h1_item(LAS unsigned char* lds, unsigned char* ws, int l, int item, int wave) {
    const int lane = lane_fresh(), tid = wave * 64 + lane, d = tid & 127, tq = tid >> 7;
    const int h = item & 7, bc = item >> 3, T0 = bc * 64;
    const size_t e0 = (size_t)(T0 + 16 * tq) * 1024 + h * 128 + d;
    const float* zp = (const float*)(ws + WS_R2) + e0; bf16_t* qp = (bf16_t*)(ws + WS_R1) + e0; const bf16_t* vp = (const bf16_t*)(ws + WS_R3) + e0;
    const float lb = ((const float*)(ws + WS_LB))[l * 1024 + h * 128 + d], omlb = 1.0f - lb;
    float bl[16], kk[16]; float run = 0.f;
#pragma unroll
    for (int i = 0; i < 16; ++i) {
        const float z = fmaxf(zp[(size_t)i * 1024], -80.f);
        const float ez = __builtin_amdgcn_exp2f(-LOG2E * z), sg = __builtin_amdgcn_rcpf(1.0f + ez);
        const float f = lb + omlb * sg; run += __logf(f); bl[i] = run; kk[i] = omlb * ez * sg;
    }
    LAS float* QS = (LAS float*)(lds + L_QS);
    QS[tq * 128 + d] = run;
    __syncthreads();
    const float s0 = QS[d], s1 = QS[128 + d], s2 = QS[256 + d], s3 = QS[384 + d];
    const float rref = s0 + s1, blast = (s0 + s1) + (s2 + s3);
    const float off = tq == 0 ? 0.f : (tq == 1 ? s0 : (tq == 2 ? s0 + s1 : (s0 + s1) + s2));
    if (tq == 3) ((float*)(ws + WS_DECAY))[(size_t)bc * 1024 + h * 128 + d] = __expf(blast);
    unsigned khp[8], vpk[8];
#pragma unroll
    for (int i = 0; i < 16; i += 2) {
        float kh2[2]; unsigned short vv[2];
#pragma unroll
        for (int j = 0; j < 2; ++j) {
            const int ii = i + j, t = 16 * tq + ii;
            const float b = bl[ii] + off, q = bf2f(qp[(size_t)ii * 1024]);
            const float ebr = __builtin_amdgcn_exp2f(LOG2E * (b - rref));
            qp[(size_t)ii * 1024] = (bf16_t)f2bf(q * __builtin_amdgcn_exp2f(LOG2E * b));
            *(LAS bf16_t*)(lds + L_QT + t * P272 + 2 * d) = (bf16_t)f2bf(q * ebr);
            *(LAS bf16_t*)(lds + L_KT + t * P272 + 2 * d) = (bf16_t)f2bf(kk[ii] * __builtin_amdgcn_exp2f(LOG2E * (rref - b)));
            kh2[j] = kk[ii] * __builtin_amdgcn_exp2f(LOG2E * (blast - b));
            vv[j] = vp[(size_t)ii * 1024];
        }
        khp[i >> 1] = cvtpk(kh2[0], kh2[1]); vpk[i >> 1] = (unsigned)vv[0] | ((unsigned)vv[1] << 16);
    }
    *(LAS v4u*)(lds + L_KH + d * P144 + 32 * tq) = (v4u){khp[0], khp[1], khp[2], khp[3]}; *(LAS v4u*)(lds + L_KH + d * P144 + 32 * tq + 16) = (v4u){khp[4], khp[5], khp[6], khp[7]};
    *(LAS v4u*)(lds + L_VT + d * P144 + 32 * tq) = (v4u){vpk[0], vpk[1], vpk[2], vpk[3]}; *(LAS v4u*)(lds + L_VT + d * P144 + 32 * tq + 16) = (v4u){vpk[4], vpk[5], vpk[6], vpk[7]};
    __syncthreads();
    const int a = lane & 31, hh = lane >> 5, ei = wave >> 1, ti = wave & 1;
    f32x16 y;
#pragma unroll
    for (int r = 0; r < 16; ++r) y[r] = 0.f;
    for (int si = 0; si <= ti; ++si) {
        f32x16 x;
#pragma unroll
        for (int r = 0; r < 16; ++r) x[r] = 0.f;
#pragma unroll
        for (int c = 0; c < 8; ++c) {
            const bf16x8 kf = *(const LAS bf16x8*)(lds + L_KT + (32 * si + a) * P272 + 32 * c + 16 * hh);
            const bf16x8 qf = *(const LAS bf16x8*)(lds + L_QT + (32 * ti + a) * P272 + 32 * c + 16 * hh);
            x = MFMA32(kf, qf, x);
        }
        if (si == ti) {
#pragma unroll
            for (int r = 0; r < 16; ++r) { const int s = (r & 3) + 8 * (r >> 2) + 4 * hh; if (s > a) x[r] = 0.f; }
        }
#pragma unroll
        for (int ks = 0; ks < 2; ++ks) {
            v4u w; w.x = cvtpk(x[8 * ks], x[8 * ks + 1]); w.y = cvtpk(x[8 * ks + 2], x[8 * ks + 3]); w.z = cvtpk(x[8 * ks + 4], x[8 * ks + 5]); w.w = cvtpk(x[8 * ks + 6], x[8 * ks + 7]);
            const LAS unsigned char* vb = lds + L_VT + (32 * ei + a) * P144 + 64 * si + 32 * ks + 8 * hh;
            const v2u lo = *(const LAS v2u*)vb, hi = *(const LAS v2u*)(vb + 16);
            y = MFMA32(__builtin_bit_cast(bf16x8, ((v4u){lo.x, lo.y, hi.x, hi.y})), __builtin_bit_cast(bf16x8, w), y);
        }
    }
    {
        bf16_t* op = (bf16_t*)(ws + WS_R3) + (size_t)(T0 + 32 * ti + a) * 1024 + h * 128 + 32 * ei + 4 * hh;
#pragma unroll
        for (int g = 0; g < 4; ++g) *(v2u*)(op + 8 * g) = (v2u){cvtpk(y[4 * g], y[4 * g + 1]), cvtpk(y[4 * g + 2], y[4 * g + 3])};
    }
#pragma unroll
    for (int dd = 0; dd < 2; ++dd) {
        const int di = 2 * ti + dd;
#pragma unroll
        for (int r = 0; r < 16; ++r) y[r] = 0.f;
#pragma unroll
        for (int ks = 0; ks < 4; ++ks) {
            const bf16x8 kh = *(const LAS bf16x8*)(lds + L_KH + (32 * di + a) * P144 + 32 * ks + 16 * hh);
            const bf16x8 vf = *(const LAS bf16x8*)(lds + L_VT + (32 * ei + a) * P144 + 32 * ks + 16 * hh);
            y = MFMA32(kh, vf, y);
        }
        unsigned char* sp = ws + WS_R2 + st_off(T0, h, 32 * ei + a) + 2 * (32 * di + 4 * hh);
#pragma unroll
        for (int g = 0; g < 4; ++g) *(v2u*)(sp + 16 * g) = (v2u){cvtpk(y[4 * g], y[4 * g + 1]), cvtpk(y[4 * g + 2], y[4 * g + 3])};
    }
    __syncthreads();
}
__device__ __forceinline__ void h1_phase(LAS unsigned char* lds, unsigned char* ws, int l, int wave) {
    for (int it = blockIdx.x; it < (T / 64) * 8; it += gridDim.x) h1_item(lds, ws, l, it, wave);
}

__device__ __forceinline__ void h2_phase(unsigned char* ws, int wave) {
    const int lane = lane_fresh();
    for (int row = blockIdx.x * NWAVES + wave; row < NB * 8 * 128; row += gridDim.x * NWAVES) {
        const int e = row & 127, h = (row >> 7) & 7, b = row >> 10;
        unsigned char* sp = ws + WS_R2 + st_off(b * SEQ, h, e) + 4 * lane;
        const float* dc = (const float*)(ws + WS_DECAY) + (size_t)b * 128 * 1024 + h * 128 + 2 * lane;
        float s0 = 0.f, s1 = 0.f;
        for (int c0 = 0; c0 < NCH; c0 += 8) {
            unsigned dsv[8]; float2 dv[8];
#pragma unroll
            for (int j = 0; j < 8; ++j) { dsv[j] = *(const unsigned*)(sp + (size_t)(c0 + j) * 64 * 4096); dv[j] = *(const float2*)(dc + (size_t)(c0 + j) * 1024); }
#pragma unroll
            for (int j = 0; j < 8; ++j) {
                *(unsigned*)(sp + (size_t)(c0 + j) * 64 * 4096) = cvtpk(s0, s1);
                s0 = fmaf(dv[j].x, s0, bf2f(dsv[j] & 0xffff)); s1 = fmaf(dv[j].y, s1, bf2f(dsv[j] >> 16));
            }
        }
    }
}

constexpr int L3_ST = 0, L3_QH = 128 * P272, L3_OT = L3_QH + 64 * P272, OTP = 132, H3_LDS = L3_OT + 64 * OTP * 4;
__device__ __forceinline__ void h3_item(LAS unsigned char* lds, unsigned char* ws, const float* out_g, int item, int wave) {
    const int lane = lane_fresh(), tid = wave * 64 + lane;
    const int h = item & 7, bc = item >> 3, T0 = bc * 64;
#pragma unroll
    for (int j = 0; j < 4; ++j) { const int idx = tid + 512 * j, e = idx >> 4, ch = idx & 15; *(LAS v4u*)(lds + L3_ST + e * P272 + 16 * ch) = *(const v4u*)(ws + WS_R2 + st_off(T0, h, e) + 16 * ch); }
#pragma unroll
    for (int j = 0; j < 2; ++j) { const int idx = tid + 512 * j, t = idx >> 4, ch = idx & 15; *(LAS v4u*)(lds + L3_QH + t * P272 + 16 * ch) = *(const v4u*)((const bf16_t*)(ws + WS_R1) + (size_t)(T0 + t) * 1024 + h * 128 + 8 * ch); }
    __syncthreads();
    {
        const int a = lane & 31, hh = lane >> 5, ei = wave >> 1, ti = wave & 1;
        f32x16 y;
#pragma unroll
        for (int r = 0; r < 16; ++r) y[r] = 0.f;
#pragma unroll
        for (int c = 0; c < 8; ++c) {
            const bf16x8 sf = *(const LAS bf16x8*)(lds + L3_ST + (32 * ei + a) * P272 + 32 * c + 16 * hh);
            const bf16x8 qf = *(const LAS bf16x8*)(lds + L3_QH + (32 * ti + a) * P272 + 32 * c + 16 * hh);
            y = MFMA32(sf, qf, y);
        }
        LAS float* ot = (LAS float*)(lds + L3_OT) + (32 * ti + a) * OTP + 32 * ei + 4 * hh;
#pragma unroll
        for (int g = 0; g < 4; ++g) *(LAS f32x4*)(ot + 8 * g) = (f32x4){y[4 * g], y[4 * g + 1], y[4 * g + 2], y[4 * g + 3]};
    }
    __syncthreads();
    {
        const int t = tid >> 3, part = tid & 7;
        const LAS float* ot = (const LAS float*)(lds + L3_OT) + t * OTP + 16 * part;
        const size_t go = (size_t)(T0 + t) * 1024 + h * 128 + 16 * part;
        const v4u i0 = *(const v4u*)((const bf16_t*)(ws + WS_R3) + go), i1 = *(const v4u*)((const bf16_t*)(ws + WS_R3) + go + 8);
        const unsigned iw[8] = {i0.x, i0.y, i0.z, i0.w, i1.x, i1.y, i1.z, i1.w};
        float o[16]; float ss = 0.f;
#pragma unroll
        for (int j = 0; j < 8; ++j) { o[2 * j] = ot[2 * j] + bf2f(iw[j] & 0xffff); o[2 * j + 1] = ot[2 * j + 1] + bf2f(iw[j] >> 16); ss += o[2 * j] * o[2 * j] + o[2 * j + 1] * o[2 * j + 1]; }
        ss += shx<1>(ss); ss += shx<2>(ss); ss += shx<4>(ss);
        const float rs = 1.0f / sqrtf(ss * (1.0f / 128.0f) + RMS_EPS);
        bf16_t* mix = (bf16_t*)(ws + WS_MIX) + (size_t)(T0 + t) * MIXW + h * 128 + 16 * part;
        const v4u g0 = *(const v4u*)mix, g1 = *(const v4u*)(mix + 8);
        const unsigned gw[8] = {g0.x, g0.y, g0.z, g0.w, g1.x, g1.y, g1.z, g1.w};
        unsigned ow[8];
#pragma unroll
        for (int j = 0; j < 8; ++j) ow[j] = cvtpk(o[2 * j] * rs * out_g[16 * part + 2 * j] * bf2f(gw[j] & 0xffff), o[2 * j + 1] * rs * out_g[16 * part + 2 * j + 1] * bf2f(gw[j] >> 16));
        *(v4u*)mix = (v4u){ow[0], ow[1], ow[2], ow[3]}; *(v4u*)(mix + 8) = (v4u){ow[4], ow[5], ow[6], ow[7]};
    }
    __syncthreads();
}
__device__ __forceinline__ void h3_phase(LAS unsigned char* lds, unsigned char* ws, const float* out_g, int wave) {
    for (int it = blockIdx.x; it < (T / 64) * 8; it += gridDim.x) h3_item(lds, ws, out_g, it, wave);
}
}

constexpr int LDS_BYTES = 147456;
__device__ __forceinline__ float wave_sum(float v) {
    v += shx<1>(v); v += shx<2>(v); v += shx<4>(v); v += shx<8>(v); v += shx<16>(v);
    return xsum32(v);
}

__device__ __forceinline__ void conv_layer_weights(const Ptrs& p, int l, LAS float* scr, int gw, int ngw, int lane) {
    constexpr int I_IN = (DM / 64) * (NWIN / 32), I_OUT = (MIXW / 64) * (DM / 32);
    bf16_t* win = (bf16_t*)(p.ws + WS_WIN); bf16_t* wout = (bf16_t*)(p.ws + WS_WOUT);
    for (int it = gw; it < I_IN + I_OUT; it += ngw) {
        if (it < I_IN) transpose_item<1>(p.w_in + (size_t)l * DM * INW, DM, INW, NWIN, nullptr, win, scr, it, lane);
        else transpose_item<0>(p.w_out + (size_t)l * MIXW * DM, MIXW, DM, DM, nullptr, wout, scr, it - I_IN, lane);
    }
}

__device__ __forceinline__ void phase_prologue(const Ptrs& p, LAS unsigned char* lds, int wave) {
    const int lane = att::lane_fresh(), gw = blockIdx.x * NWAVES + wave, ngw = gridDim.x * NWAVES;
    LAS float* scr = (LAS float*)(lds + wave * 16384);
    conv_layer_weights(p, 0, scr, gw, ngw, lane);
    {
        constexpr int I_UQ = (256 / 64) * (768 / 32), I_UK = (128 / 64) * (512 / 32);
        for (int it = gw; it < 2 * (I_UQ + 2 * I_UK); it += ngw) {
            const int l = it / (I_UQ + 2 * I_UK); int r = it % (I_UQ + 2 * I_UK);
            if (r < I_UQ) { transpose_item<2>(p.w_uq + (size_t)l * 256 * 768, 256, 768, 768, p.q_norm + l * 256, (bf16_t*)(p.ws + WS_WUQ) + (size_t)l * 768 * 256, scr, r, lane); continue; } r -= I_UQ;
            if (r < I_UK) { transpose_item<0>(p.w_uk + (size_t)l * 128 * 512, 128, 512, 512, p.kv_norm + l * 128, (bf16_t*)(p.ws + WS_WUK) + (size_t)l * 512 * 128, scr, r, lane); continue; } r -= I_UK;
            transpose_item<0>(p.w_uv + (size_t)l * 128 * 512, 128, 512, 512, p.kv_norm + l * 128, (bf16_t*)(p.ws + WS_WUV) + (size_t)l * 512 * 128, scr, r, lane);
        }
    }
    for (int m = gw; m < T; m += ngw) {
        const f32x4* xr = (const f32x4*)(p.x + (size_t)m * DM) + lane; v2u* o = (v2u*)((bf16_t*)(p.ws + WS_XN) + (size_t)m * DM) + lane;
#pragma unroll
        for (int j = 0; j < 4; ++j) { const f32x4 v = xr[64 * j]; v2u w; w.x = pk2(v.x, v.y); w.y = pk2(v.z, v.w); o[64 * j] = w; }
    }
    const int gt = gw * 64 + lane, ngt = ngw * 64;
    for (int i = gt; i < T * 16; i += ngt) {
        const int t = i >> 4, j = i & 15;
        const double inv = pow(10000.0, -(double)j / 16.0); const double ang = (double)p.pos[t] * inv;
        ((float*)(p.ws + WS_COS))[i] = (float)cos(ang); ((float*)(p.ws + WS_SIN))[i] = (float)sin(ang);
    }
    for (int i = gt; i < 1024; i += ngt) {
        float* lb = (float*)(p.ws + WS_LB); lb[i] = 0.f;
        const float a = p.lb_logits[i], b = p.lb_logits[1024 + i]; lb[1024 + i] = 1.0f / (1.0f + expf(a - b));
    }
    for (int i = gt; i < 2 * 2 * 512 * 512; i += ngt) {
        const int c = i & 511, r = (i >> 9) & 511, kv = (i >> 18) & 1, l = i >> 19;
        const float* w = (kv ? p.w_mv : p.w_mk) + (size_t)l * 1024 * 512 + c; const float* mr = p.mem + (size_t)r * 1024;
        float acc = 0.f;
        for (int k = 0; k < 1024; ++k) acc = fmaf(mr[k], w[(size_t)k * 512], acc);
        const int b = r >> 8, m = r & 255, h = c >> 7, d = c & 127;
        if (kv == 0) ((bf16_t*)(p.ws + WS_KMEM))[((size_t)((l * 2 + b) * 4 + h) * 256 + m) * 128 + d] = (bf16_t)f2bf(acc);
        else ((bf16_t*)(p.ws + WS_VMEMT))[((size_t)((l * 2 + b) * 4 + h) * 128 + d) * 256 + m] = (bf16_t)f2bf(acc);
    }
}

__device__ __forceinline__ void phase_ln(const Ptrs& p, int l, LAS unsigned char* lds, int wave) {
    const int lane = att::lane_fresh(), gw = blockIdx.x * NWAVES + wave, ngw = gridDim.x * NWAVES;
    const float* g = p.ln_g + l * DM; const float* bt = p.ln_b + l * DM;
    for (int m = gw; m < T; m += ngw) {
        f32x4* xr = (f32x4*)(p.out + (size_t)m * DM) + lane;
        f32x4 v[4]; float s = 0.f;
#pragma unroll
        for (int j = 0; j < 4; ++j) { v[j] = xr[64 * j]; s += (v[j].x + v[j].y) + (v[j].z + v[j].w); }
        const float mean = wave_sum(s) * (1.f / DM); float s2 = 0.f;
#pragma unroll
        for (int j = 0; j < 4; ++j) { v[j] = v[j] - mean; s2 += (v[j].x * v[j].x + v[j].y * v[j].y) + (v[j].z * v[j].z + v[j].w * v[j].w); }
        const float rstd = 1.f / sqrtf(wave_sum(s2) * (1.f / DM) + LN_EPS);
        v2u* o = (v2u*)((bf16_t*)(p.ws + WS_XN) + (size_t)m * DM) + lane;
#pragma unroll
        for (int j = 0; j < 4; ++j) {
            const f32x4 gg = *((const f32x4*)g + lane + 64 * j), bb = *((const f32x4*)bt + lane + 64 * j);
            const f32x4 y = v[j] * rstd * gg + bb; xr[64 * j] = y;
            v2u w; w.x = pk2(y.x, y.y); w.y = pk2(y.z, y.w); o[64 * j] = w;
        }
    }
    if (l + 1 < DEPTH) conv_layer_weights(p, l + 1, (LAS float*)(lds + wave * 16384), gw, ngw, lane);
}


__device__ __forceinline__ void krope_phase(unsigned char* ws, int wave) {
    const int lane = att::lane_fresh();
    for (int i = (blockIdx.x * NWAVES + wave) * 64 + lane; i < T * 16; i += gridDim.x * NTHR) {
        const int t = i >> 4, j = i & 15;
        const float* raw = (const float*)(ws + WS_R3 + R3_KRRAW) + (size_t)t * 32 + 2 * j;
        const float c = ((const float*)(ws + WS_COS))[i], s = ((const float*)(ws + WS_SIN))[i];
        const float a = raw[0], b = raw[1];
        *(unsigned*)((bf16_t*)(ws + WS_R2 + R2_KR) + (size_t)t * 32 + 2 * j) = pk2(a * c - b * s, a * s + b * c);
    }
}

namespace cg = cooperative_groups;
struct Args { Ptrs p; };
#define CAS __attribute__((address_space(4)))
__device__ __forceinline__ Ptrs load_ptrs(const CAS Args* ka) {
    Ptrs p; p.x = ka->p.x; p.mem = ka->p.mem; p.pos = ka->p.pos; p.w_in = ka->p.w_in; p.lb_logits = ka->p.lb_logits; p.out_norm = ka->p.out_norm; p.q_norm = ka->p.q_norm; p.kv_norm = ka->p.kv_norm;
    p.w_uq = ka->p.w_uq; p.w_uk = ka->p.w_uk; p.w_uv = ka->p.w_uv; p.w_mk = ka->p.w_mk; p.w_mv = ka->p.w_mv; p.w_out = ka->p.w_out; p.ln_g = ka->p.ln_g; p.ln_b = ka->p.ln_b; p.out = ka->p.out; p.ws = ka->p.ws; return p;
}
#define PHASE_ENV() const CAS Args* ka = (const CAS Args*)__builtin_amdgcn_kernarg_segment_ptr(); asm volatile("" : "+s"(ka)); int lf = l; asm volatile("" : "+s"(lf)); unsigned char* ws = ka->p.ws; (void)lf; (void)ws
#define GRID_BAR() grid.sync()
template <int l> __device__ __forceinline__ void layer_program(LAS unsigned char* lds, const int wave, const cg::grid_group& grid) {
        {
            PHASE_ENV();
            pg8::Gemm g{(const bf16_t*)(ws + WS_XN), (const bf16_t*)(ws + WS_WIN) + (size_t)G1_ROW0 * DM, T, G1_N, DM, DM, DM}; pg8::StaticOrder S; S.init(T, G1_N, gridDim.x, blockIdx.x);
            pg8::gemm_phase<pg8::EpiG1v, pg8::StaticOrder, true, true>(lds, g, S, pg8::EpiG1v{ws}, wave);
        }
        GRID_BAR();
        {
            { PHASE_ENV(); pg8::Gemm g{(const bf16_t*)(ws + WS_R3 + R3_CQ), (const bf16_t*)(ws + WS_WUQ) + (size_t)lf * 768 * 256, T, 768, 256, 256, 256}; pg8::StaticOrder S; S.init(T, 768, gridDim.x, blockIdx.x);
              pg8::gemm_phase<pg8::EpiQv, pg8::StaticOrder, true, true>(lds, g, S, pg8::EpiQv{ws}, wave); }
            __syncthreads();
            { PHASE_ENV(); pg8::Gemm g{(const bf16_t*)(ws + WS_R3 + R3_CKV), (const bf16_t*)(ws + WS_WUK) + (size_t)lf * 512 * 128, T, 512, 128, 128, 128}; pg8::StaticOrder S; S.init(T, 512, gridDim.x, blockIdx.x);
              pg8::gemm_phase<pg8::EpiKnv, pg8::StaticOrder, true, true>(lds, g, S, pg8::EpiKnv{ws}, wave); }
            __syncthreads();
            { PHASE_ENV(); pg8::Gemm g{(const bf16_t*)(ws + WS_WUV) + (size_t)lf * 512 * 128, (const bf16_t*)(ws + WS_R3 + R3_CKV), 512, T, 128, 128, 128}; pg8::StaticOrder S; S.init(512, T, gridDim.x, blockIdx.x);
              pg8::gemm_phase<pg8::EpiVtv, pg8::StaticOrder, true, true>(lds, g, S, pg8::EpiVtv{ws}, wave); }
            __syncthreads();
            { PHASE_ENV(); krope_phase(ws, wave); }
            { PHASE_ENV(); att::mem_phase(lds, ws, lf, wave); }
        }
        GRID_BAR();
        { PHASE_ENV(); att::mla_phase(lds, ws, wave); }
        GRID_BAR();
        {
            PHASE_ENV();
            pg8::Gemm g{(const bf16_t*)(ws + WS_XN), (const bf16_t*)(ws + WS_WIN) + (size_t)G2_ROW0 * DM, T, G2_N, DM, DM, DM}; pg8::StaticOrder S; S.init(T, G2_N, gridDim.x, blockIdx.x);
            pg8::gemm_phase<pg8::EpiG2v, pg8::StaticOrder, true, true>(lds, g, S, pg8::EpiG2v{ws}, wave);
        }
        GRID_BAR();
        { PHASE_ENV(); hg::h1_phase(lds, ws, lf, wave); }
        GRID_BAR();
        { PHASE_ENV(); hg::h2_phase(ws, wave); }
        GRID_BAR();
        { PHASE_ENV(); hg::h3_phase(lds, ws, ka->p.out_norm + lf * 128, wave); }
        GRID_BAR();
        {
            PHASE_ENV();
            pg8::Gemm g{(const bf16_t*)(ws + WS_MIX), (const bf16_t*)(ws + WS_WOUT), T, DM, MIXW, MIXW, MIXW}; pg8::StaticOrder S; S.init(T, DM, gridDim.x, blockIdx.x);
            float* outp = ka->p.out; const float* xres = lf == 0 ? ka->p.x : (const float*)outp;
            pg8::gemm_phase<pg8::EpiOutv, pg8::StaticOrder, true, true>(lds, g, S, pg8::EpiOutv{xres, outp}, wave);
        }
        GRID_BAR();
        { PHASE_ENV(); const Ptrs p = load_ptrs(ka); phase_ln(p, lf, lds, wave); }
}
__global__ void __launch_bounds__(NTHR, 2) mk(Args a) {
    extern __shared__ __attribute__((aligned(16))) unsigned char lds_raw[];
    LAS unsigned char* lds = (LAS unsigned char*)lds_raw;
    const int wave = __builtin_amdgcn_readfirstlane(threadIdx.x >> 6);
    cg::grid_group grid = cg::this_grid();
    { const int l = 0; PHASE_ENV(); const Ptrs p = load_ptrs(ka); phase_prologue(p, lds, wave); }
    GRID_BAR();
    layer_program<0>(lds, wave, grid);
    GRID_BAR();
    layer_program<1>(lds, wave, grid);
}

extern "C" void kernel_launch(void* const* d_in, const int* in_sizes, int n_in, void* d_out, int out_size, void* d_ws, size_t ws_size, hipStream_t stream) {
    static int grid = 0;
    if (grid == 0) {
        if (n_in != 16 || in_sizes[0] != T * DM || out_size != T * DM || ws_size < WS_END) { fprintf(stderr, "kernel_launch: unexpected shapes (n_in %d, ws %zu)\n", n_in, ws_size); grid = -1; return; }
        if (hipFuncSetAttribute((const void*)mk, hipFuncAttributeMaxDynamicSharedMemorySize, LDS_BYTES) != hipSuccess) { fprintf(stderr, "kernel_launch: hipFuncSetAttribute failed\n"); grid = -1; return; }
        int dev = 0, cus = 0, per_cu = 0;
        hipGetDevice(&dev); hipDeviceGetAttribute(&cus, hipDeviceAttributeMultiprocessorCount, dev);
        hipOccupancyMaxActiveBlocksPerMultiprocessor(&per_cu, (const void*)mk, NTHR, LDS_BYTES);
        if (per_cu < 1 || cus < 1) { fprintf(stderr, "kernel_launch: occupancy query gave %d blocks/CU on %d CUs\n", per_cu, cus); grid = -1; return; }
        grid = cus;
    }
    if (grid < 0) return;
    Args a{};
    a.p.x = (const float*)d_in[0]; a.p.mem = (const float*)d_in[1]; a.p.pos = (const int*)d_in[2]; a.p.w_in = (const float*)d_in[3];
    a.p.lb_logits = (const float*)d_in[4]; a.p.out_norm = (const float*)d_in[5]; a.p.q_norm = (const float*)d_in[6]; a.p.kv_norm = (const float*)d_in[7];
    a.p.w_uq = (const float*)d_in[8]; a.p.w_uk = (const float*)d_in[9]; a.p.w_uv = (const float*)d_in[10]; a.p.w_mk = (const float*)d_in[11]; a.p.w_mv = (const float*)d_in[12];
    a.p.w_out = (const float*)d_in[13]; a.p.ln_g = (const float*)d_in[14]; a.p.ln_b = (const float*)d_in[15];
    a.p.out = (float*)d_out; a.p.ws = (unsigned char*)d_ws;
    void* args[] = {&a};
    const hipError_t e = hipLaunchCooperativeKernel((const void*)mk, dim3(grid), dim3(NTHR), args, LDS_BYTES, stream);
    if (e != hipSuccess) fprintf(stderr, "kernel_launch: cooperative launch failed: %s (grid %d)\n", hipGetErrorString(e), grid);
}
```

```cpp
#include <hip/hip_runtime.h>
#include <hip/hip_cooperative_groups.h>
#include <cstdio>
#include <cstdint>

#define GAS __attribute__((address_space(1)))
#define LAS __attribute__((address_space(3)))
typedef unsigned short bf16_t;
typedef unsigned v4u __attribute__((ext_vector_type(4)));
typedef unsigned v2u __attribute__((ext_vector_type(2)));
typedef float f32x4 __attribute__((ext_vector_type(4)));

constexpr int NB = 2, SEQ = 8192, T = NB * SEQ, DM = 1024, DEPTH = 2, MEML = 256;
constexpr int INW = 6048, MIXW = 2048, NWIN = 6144;
constexpr int G2_ROW0 = 0, G2_N = 4096, G1_ROW0 = 4096, G1_N = 2048;
constexpr int CHUNK = 64, NCH = SEQ / CHUNK;
constexpr float ALPHA = 1.4142135623730951f;
constexpr float RMS_EPS = 1e-6f, LN_EPS = 1e-5f;
constexpr float LOG2E = 1.4426950408889634f;
constexpr float C2_MLA = LOG2E * 0.10206207261596575f;
constexpr float C2_MEM = LOG2E * 0.08838834764831845f;

constexpr size_t MiB = 1u << 20;
constexpr size_t WS_CTL = 0, CTL_BYTES = 1 * MiB;
constexpr size_t WS_WIN = 1 * MiB;
constexpr size_t WS_WOUT = 13 * MiB;
constexpr size_t WS_WUQ = 17 * MiB;
constexpr size_t WS_WUK = 18 * MiB;
constexpr size_t WS_WUV = 18 * MiB + 512 * 1024;
constexpr size_t WS_KMEM = 19 * MiB;
constexpr size_t WS_VMEMT = 20 * MiB;
constexpr size_t WS_COS = 21 * MiB, WS_SIN = 22 * MiB;
constexpr size_t WS_SSQ_CQ = 23 * MiB, WS_SSQ_CKV = 23 * MiB + 256 * 1024;
constexpr size_t WS_LB = 23 * MiB + 512 * 1024;
constexpr size_t WS_DECAY = 24 * MiB;
constexpr size_t WS_XN = 25 * MiB;
constexpr size_t WS_MIX = 57 * MiB;
constexpr size_t WS_R1 = 121 * MiB;
constexpr size_t WS_R2 = 153 * MiB;
constexpr size_t WS_R3 = 217 * MiB;
constexpr size_t WS_END = 249 * MiB;
constexpr size_t R2_KN = 0, R2_VT = 16 * MiB, R2_KR = 32 * MiB;
constexpr size_t R3_CQ = 0, R3_CKV = 8 * MiB, R3_KRRAW = 12 * MiB, R3_MEMQ = 14 * MiB;

constexpr int NTHR = 512, NWAVES = 8;
__device__ __forceinline__ unsigned f2bf(float f) { unsigned u = __builtin_bit_cast(unsigned, f); return (u + 0x7fffu + ((u >> 16) & 1u)) >> 16; }
__device__ __forceinline__ float bf2f(unsigned short b) { return __builtin_bit_cast(float, (unsigned)b << 16); }
__device__ __forceinline__ unsigned pk2(float lo, float hi) { return f2bf(lo) | (f2bf(hi) << 16); }
__device__ __forceinline__ float silu_f(float v) { return v / (1.0f + __expf(-v)); }

template <int XM> __device__ __forceinline__ float shx(float v) { static_assert(XM >= 1 && XM < 32, "ds_swizzle xor within 32 lanes"); return __builtin_bit_cast(float, __builtin_amdgcn_ds_swizzle(__builtin_bit_cast(int, v), (XM << 10) | 0x1f)); }
__device__ __forceinline__ float xsum32(float v) { const unsigned u = __builtin_bit_cast(unsigned, v); auto r = __builtin_amdgcn_permlane32_swap(u, u, false, false); return __builtin_bit_cast(float, (unsigned)r[0]) + __builtin_bit_cast(float, (unsigned)r[1]); }
__device__ __forceinline__ float xmax32(float v) { const unsigned u = __builtin_bit_cast(unsigned, v); auto r = __builtin_amdgcn_permlane32_swap(u, u, false, false); return fmaxf(__builtin_bit_cast(float, (unsigned)r[0]), __builtin_bit_cast(float, (unsigned)r[1])); }

struct Ptrs {
    const float *x, *mem; const int* pos; const float *w_in, *lb_logits, *out_norm, *q_norm, *kv_norm, *w_uq, *w_uk, *w_uv, *w_mk, *w_mv, *w_out, *ln_g, *ln_b;
    float* out; unsigned char* ws;
};

__device__ __forceinline__ int cmap_win(int n) {
    if (n < 4480) return n;
    if (n < 4512) { const int i = n - 4480; return 4480 + ((i & 1) ? 16 + (i >> 1) : (i >> 1)); }
    if (n < 4608) return -1;
    return n - 96;
}
__device__ __forceinline__ int cmap_wuq(int n) {
    const int h = n / 96, j = n - h * 96;
    if (j < 64) return n;
    const int i = j - 64; return h * 96 + 64 + ((i & 1) ? 16 + (i >> 1) : (i >> 1));
}
__device__ __forceinline__ int cmap_id(int n) { return n; }
template <int MAPK>
__device__ __forceinline__ void transpose_item(const float* W, int K, int Nsrc, int Ndst, const float* kscale, bf16_t* WT, LAS float* scr, int item, int lane) {
    const int nblk = Ndst / 32, kb = item / nblk, nb = item % nblk, k0 = 64 * kb, n0 = 32 * nb;
    const int n = n0 + (lane & 31);
    const int c = MAPK == 0 ? cmap_id(n) : (MAPK == 1 ? cmap_win(n) : cmap_wuq(n));
#pragma unroll 8
    for (int i = 0; i < 32; ++i) { const int kk = 2 * i + (lane >> 5); float v = 0.f; if (c >= 0) { v = W[(size_t)(k0 + kk) * Nsrc + c]; if (kscale) v *= kscale[k0 + kk]; } scr[kk * 33 + (lane & 31)] = v; }
    asm volatile("s_waitcnt lgkmcnt(0)" ::: "memory");
    const int cc = lane & 7;
#pragma unroll
    for (int j = 0; j < 4; ++j) { const int nn = (lane >> 3) + 8 * j; const LAS float* s = scr + (8 * cc) * 33 + nn;
        v4u o; o.x = pk2(s[0 * 33], s[1 * 33]); o.y = pk2(s[2 * 33], s[3 * 33]); o.z = pk2(s[4 * 33], s[5 * 33]); o.w = pk2(s[6 * 33], s[7 * 33]);
        *(v4u*)(WT + (size_t)(n0 + nn) * K + k0 + 8 * cc) = o; }
    asm volatile("s_waitcnt lgkmcnt(0)" ::: "memory");
}

namespace pg8 {
#define PG8_LAS __attribute__((address_space(3)))
typedef unsigned short bf16_t;
typedef short bf16x8 __attribute__((ext_vector_type(8)));
typedef float f32x4 __attribute__((ext_vector_type(4)));
typedef unsigned u32x4 __attribute__((ext_vector_type(4)));
constexpr int BM = 256, BK = 64, HALF = 128, HTB = HALF * BK * 2  , STAGE_BYTES = 8 * HTB, NXCD = 8, WGM = 8;

__host__ __device__ __forceinline__ int lds_byte(int r, int c) { const int st = (r >> 4) * 2 + (c >> 5), rr = r & 15, cc = c & 31, ob = rr * 64 + cc * 2; return st * 1024 + (ob ^ (((ob >> 9) & 1) << 5)); }
__host__ __device__ __forceinline__ void stage_rc(int b, int& R, int& C) { const int st = b / 1024, sb = b % 1024, swz = sb ^ (((sb >> 9) & 1) << 5); R = (st >> 1) * 16 + swz / 64; C = (st & 1) * 32 + (swz % 64) / 2; }
__host__ __device__ __forceinline__ int perm32(int rho) { const int n = rho >> 4, i = rho & 15; return 8 * (i >> 2) + 4 * n + (i & 3); }

struct Unit { int pm, pn; };
struct Gemm { const bf16_t* A; const bf16_t* Bt; int M, N, K, lda, ldb; };

struct StaticOrder {
    int nM, nN, nwg, G, c;
    __host__ __device__ void init(int M, int N, int G_, int c_) { nM = M / BM; nN = N / BM; nwg = nM * nN; G = G_; c = c_; }
    __host__ __device__ bool next(int i, Unit& u) const {
        const long L = (long)i * G + c; if (L >= nwg) return false;
        int wgid = (int)L; { const int q = nwg / NXCD, r = nwg % NXCD, xcd = wgid % NXCD, off = wgid / NXCD; wgid = (xcd < r ? xcd * (q + 1) : r * (q + 1) + (xcd - r) * q) + off; }
        const int nig = WGM * nN, gid = wgid / nig, fm = gid * WGM, gsz = (nM - fm) < WGM ? (nM - fm) : WGM;
        u.pm = fm + ((wgid % nig) % gsz); u.pn = (wgid % nig) / gsz; return true;
    }
    __device__ __forceinline__ void a_ready(const Unit&) const {}
    __device__ __forceinline__ void done(const Unit&) const {}
};

__device__ __forceinline__ unsigned cvt_pk_bf16(float lo, float hi) { unsigned r; asm volatile("v_cvt_pk_bf16_f32 %0, %1, %2" : "=v"(r) : "v"(lo), "v"(hi)); return r; }
template <class Epi, class Sched, bool ALIGN_EPI = false, bool SP2 = false>
__device__ __forceinline__ void gemm_phase(PG8_LAS unsigned char* lds, const Gemm g, const Sched& S, const Epi& E, const int wave_id  ) {
    int lane_; asm volatile("v_mbcnt_lo_u32_b32 %0, -1, 0\n\tv_mbcnt_hi_u32_b32 %0, -1, %0" : "=v"(lane_));
    const int wid = wave_id, lane = lane_, tid = wid * 64 + lane, wr = wid >> 2, wc = wid & 3, fr = lane & 15, fq = lane >> 4;
    const int K = g.K, nt = K / BK;
    unsigned voffA[2], voffB[2];
#pragma unroll
    for (int i = 0; i < 2; ++i) { int R, C; stage_rc(tid * 16 + i * 8192, R, C); const int Rb = Epi::PERM ? ((R & ~31) + perm32(R & 31)) : R;
        voffA[i] = (unsigned)(R * K + C) * 2u; voffB[i] = (unsigned)(Rb * K + C) * 2u; }
    const size_t kstep = (size_t)(BK * 2);
    const size_t hstepA = (size_t)HALF * K * 2;
#define hstepB hstepA
    const size_t tstepA = 2 * hstepA;
#define tstepB tstepA
    const unsigned ldsw = (unsigned)wid * 1024u;
    const int aoff = lds_byte(wr * 64 + fr, fq * 8), boff = lds_byte(wc * 32 + fr, fq * 8);
#define PG8_SA(b, h) (((b) * 2 + (h)) * HTB)
#define PG8_SB(b, h) ((4 + (b) * 2 + (h)) * HTB)
#define PG8_STAGE(bufoff, gbase, voff) do { _Pragma("unroll") for (int _i = 0; _i < 2; ++_i) \
        __builtin_amdgcn_global_load_lds((const unsigned*)((const char*)(gbase) + (voff)[_i]), (PG8_LAS unsigned*)(lds + (bufoff) + ldsw + _i * 8192), 16, 0, 0); } while (0)
#define PG8_LDA(dst, b, h) do { _Pragma("unroll") for (int m = 0; m < 4; ++m) _Pragma("unroll") for (int k = 0; k < 2; ++k) dst[m][k] = *(const PG8_LAS bf16x8*)(lds + PG8_SA(b, h) + aoff + m * 2048 + k * 1024); } while (0)
#define PG8_LDB(dst, b, h) do { _Pragma("unroll") for (int n = 0; n < 2; ++n) _Pragma("unroll") for (int k = 0; k < 2; ++k) dst[n][k] = *(const PG8_LAS bf16x8*)(lds + PG8_SB(b, h) + boff + n * 2048 + k * 1024); } while (0)
#define PG8_MMA(ai, bj, At, Bt) do { __builtin_amdgcn_s_setprio(1); _Pragma("unroll") for (int m = 0; m < 4; ++m) _Pragma("unroll") for (int n = 0; n < 2; ++n) _Pragma("unroll") for (int k = 0; k < 2; ++k) \
        acc[ai][bj][m][n] = __builtin_amdgcn_mfma_f32_16x16x32_bf16(Bt[n][k], At[m][k], acc[ai][bj][m][n], 0, 0, 0); __builtin_amdgcn_s_setprio(0); } while (0)
#define PG8_WAIT_V(n) asm volatile("s_waitcnt vmcnt(" #n ")" ::: "memory")
#define PG8_WAIT_L(n) asm volatile("s_waitcnt lgkmcnt(" #n ")" ::: "memory")
#define PG8_BAR __builtin_amdgcn_s_barrier()
#define PG8_SCHED __builtin_amdgcn_sched_barrier(0)
    Unit cur, nxt; int ui = 0;
    if (!S.next(0, cur)) return;
    f32x4 acc[2][2][4][2];
#pragma unroll
    for (int a = 0; a < 2; ++a)
#pragma unroll
        for (int b = 0; b < 2; ++b)
#pragma unroll
            for (int m = 0; m < 4; ++m)
#pragma unroll
                for (int n = 0; n < 2; ++n) acc[a][b][m][n] = (f32x4){0.f, 0.f, 0.f, 0.f};
    bf16x8 At[4][2], B0[2][2], B1[2][2];
    const char* cA = (const char*)g.A + (size_t)cur.pm * tstepA; const char* cB = (const char*)g.Bt + (size_t)cur.pn * tstepB;
    S.a_ready(cur);
    if constexpr (SP2) {
        PG8_STAGE(PG8_SB(0, 0), cB, voffB); PG8_STAGE(PG8_SB(0, 1), cB + hstepB, voffB); PG8_STAGE(PG8_SA(0, 0), cA, voffA); PG8_STAGE(PG8_SA(0, 1), cA + hstepA, voffA);
        if (wr == 1) PG8_BAR;
        PG8_WAIT_V(2); PG8_BAR;
        PG8_STAGE(PG8_SB(1, 0), cB + kstep, voffB); PG8_STAGE(PG8_SA(1, 0), cA + kstep, voffA); PG8_STAGE(PG8_SB(1, 1), cB + hstepB + kstep, voffB);
        PG8_WAIT_V(6); PG8_BAR;
    } else {
        PG8_STAGE(PG8_SB(0, 0), cB, voffB); PG8_STAGE(PG8_SA(0, 0), cA, voffA); PG8_STAGE(PG8_SB(0, 1), cB + hstepB, voffB); PG8_STAGE(PG8_SA(0, 1), cA + hstepA, voffA);
        if (wr == 1) PG8_BAR;
        PG8_WAIT_V(4); PG8_BAR;
        PG8_STAGE(PG8_SB(1, 0), cB + kstep, voffB); PG8_STAGE(PG8_SA(1, 0), cA + kstep, voffA); PG8_STAGE(PG8_SB(1, 1), cB + hstepB + kstep, voffB);
        PG8_WAIT_V(6); PG8_BAR;
    }
    for (;;) {
        const bool has_next = S.next(ui + 1, nxt);
        const char* nA = has_next ? (const char*)g.A + (size_t)nxt.pm * tstepA : cA; const char* nB = has_next ? (const char*)g.Bt + (size_t)nxt.pn * tstepB : cB;
        for (int t = 0; t < nt; t += 2) {
            const bool last = (t == nt - 2);
            const char* a1 = cA + (size_t)(t + 1) * kstep;
            const char* a2 = last ? nA : cA + (size_t)(t + 2) * kstep; const char* b2 = last ? nB : cB + (size_t)(t + 2) * kstep;
            const char* a3 = a2 + kstep; const char* b3 = b2 + kstep;
            if (last && has_next) S.a_ready(nxt);
            if constexpr (SP2) {
            PG8_LDB(B0, 0, 0); PG8_LDB(B1, 0, 1); PG8_SCHED; PG8_LDA(At, 0, 0); PG8_STAGE(PG8_SA(1, 1), a1 + hstepA, voffA);
            PG8_WAIT_V(8); PG8_WAIT_L(0); PG8_BAR; PG8_MMA(0, 0, At, B0); PG8_MMA(0, 1, At, B1); PG8_BAR; PG8_SCHED;
            PG8_LDA(At, 0, 1); PG8_STAGE(PG8_SB(0, 0), b2, voffB); PG8_STAGE(PG8_SB(0, 1), b2 + hstepB, voffB); PG8_STAGE(PG8_SA(0, 0), a2, voffA);
            PG8_WAIT_V(8); PG8_WAIT_L(0); PG8_BAR; PG8_MMA(1, 0, At, B0); PG8_MMA(1, 1, At, B1); PG8_BAR; PG8_SCHED;
            PG8_LDB(B0, 1, 0); PG8_LDB(B1, 1, 1); PG8_SCHED; PG8_LDA(At, 1, 0); PG8_STAGE(PG8_SA(0, 1), a2 + hstepA, voffA);
            PG8_WAIT_V(8); PG8_WAIT_L(0); PG8_BAR; PG8_MMA(0, 0, At, B0); PG8_MMA(0, 1, At, B1); PG8_BAR; PG8_SCHED;
            PG8_LDA(At, 1, 1); PG8_STAGE(PG8_SB(1, 0), b3, voffB); PG8_STAGE(PG8_SB(1, 1), b3 + hstepB, voffB); PG8_STAGE(PG8_SA(1, 0), a3, voffA);
            PG8_WAIT_V(8); PG8_WAIT_L(0); PG8_BAR; PG8_MMA(1, 0, At, B0); PG8_MMA(1, 1, At, B1); PG8_BAR; PG8_SCHED;
            } else {
            PG8_LDB(B0, 0, 0); PG8_SCHED; PG8_LDA(At, 0, 0); PG8_STAGE(PG8_SA(1, 1), a1 + hstepA, voffA);
            PG8_WAIT_L(8); PG8_BAR; PG8_WAIT_L(0); PG8_MMA(0, 0, At, B0); PG8_BAR; PG8_SCHED;
            PG8_LDB(B1, 0, 1); PG8_STAGE(PG8_SB(0, 0), b2, voffB);
            PG8_BAR; PG8_WAIT_L(0); PG8_MMA(0, 1, At, B1); PG8_BAR;
            PG8_LDA(At, 0, 1); PG8_STAGE(PG8_SA(0, 0), a2, voffA);
            PG8_BAR; PG8_WAIT_L(0); PG8_MMA(1, 0, At, B0); PG8_BAR; PG8_SCHED;
            PG8_STAGE(PG8_SB(0, 1), b2 + hstepB, voffB);
            PG8_WAIT_V(6); PG8_BAR; PG8_MMA(1, 1, At, B1); PG8_BAR;
            PG8_LDB(B0, 1, 0); PG8_SCHED; PG8_LDA(At, 1, 0); PG8_STAGE(PG8_SA(0, 1), a2 + hstepA, voffA);
            PG8_WAIT_L(8); PG8_BAR; PG8_WAIT_L(0); PG8_MMA(0, 0, At, B0); PG8_BAR; PG8_SCHED;
            PG8_LDB(B1, 1, 1); PG8_STAGE(PG8_SB(1, 0), b3, voffB);
            PG8_BAR; PG8_WAIT_L(0); PG8_MMA(0, 1, At, B1); PG8_BAR;
            PG8_LDA(At, 1, 1); PG8_STAGE(PG8_SA(1, 0), a3, voffA);
            PG8_BAR; PG8_WAIT_L(0); PG8_MMA(1, 0, At, B0); PG8_BAR; PG8_SCHED;
            PG8_STAGE(PG8_SB(1, 1), b3 + hstepB, voffB);
            PG8_WAIT_V(6); PG8_BAR; PG8_MMA(1, 1, At, B1); PG8_BAR;
            }
        }
        if constexpr (ALIGN_EPI) { if (wr == 0) PG8_BAR; }
        if constexpr (!Epi::AFTER_DRAIN) { E(acc, cur, wr, wc, fr, fq); S.done(cur); }
        if (!has_next) break;
#pragma unroll
        for (int a = 0; a < 2; ++a)
#pragma unroll
            for (int b = 0; b < 2; ++b)
#pragma unroll
                for (int m = 0; m < 4; ++m)
#pragma unroll
                    for (int n = 0; n < 2; ++n) acc[a][b][m][n] = (f32x4){0.f, 0.f, 0.f, 0.f};
        cur = nxt; cA = nA; cB = nB; ++ui;
        if constexpr (ALIGN_EPI) { if (wr == 1) PG8_BAR; }
    }
    PG8_WAIT_V(0);
    if constexpr (!ALIGN_EPI) { if (wr == 0) PG8_BAR; }
    PG8_BAR;
    if constexpr (Epi::AFTER_DRAIN) { E.fused(acc, cur, wr, wc, fr, fq, lds, wid, lane); S.done(cur); }
#undef hstepB
#undef tstepB
#undef PG8_SA
#undef PG8_SB
#undef PG8_STAGE
#undef PG8_LDA
#undef PG8_LDB
#undef PG8_MMA
#undef PG8_WAIT_V
#undef PG8_WAIT_L
#undef PG8_BAR
#undef PG8_SCHED
}
}

namespace pg8 {
__device__ __forceinline__ float silu_fast(float v) { return v * __builtin_amdgcn_rcpf(1.0f + __builtin_amdgcn_exp2f(-1.4426950408889634f * v)); }
__device__ __forceinline__ u32x4 pack8(const f32x4 a, const f32x4 b) { u32x4 w; w.x = cvt_pk_bf16(a[0], a[1]); w.y = cvt_pk_bf16(a[2], a[3]); w.z = cvt_pk_bf16(b[0], b[1]); w.w = cvt_pk_bf16(b[2], b[3]); return w; }
__device__ __forceinline__ f32x4 silu4(const f32x4 a) { return (f32x4){silu_fast(a[0]), silu_fast(a[1]), silu_fast(a[2]), silu_fast(a[3])}; }
__device__ __forceinline__ float sq4(const f32x4 a) { return (a[0] * a[0] + a[1] * a[1]) + (a[2] * a[2] + a[3] * a[3]); }
#define EPI_ROWS_BEGIN _Pragma("unroll") for (int ai = 0; ai < 2; ++ai) _Pragma("unroll") for (int m = 0; m < 4; ++m) { const int row = u.pm * BM + ai * HALF + wr * 64 + m * 16 + fr;
#define EPI_ROWS_END asm volatile("" ::: "memory"); }

struct EpiG1v {
    static constexpr bool PERM = true, AFTER_DRAIN = false; unsigned char* ws;
    __device__ __forceinline__ void operator()(const f32x4 (&acc)[2][2][4][2], const Unit& u, int wr, int wc, int fr, int fq) const {
        const int pn = u.pn, ct = wc * 32 + 8 * fq;
        if (pn == 0) {
            EPI_ROWS_BEGIN
                bf16_t* o = (bf16_t*)(ws + WS_R3 + R3_CQ) + (size_t)row * 256 + ct;
                *(u32x4*)o = pack8(acc[ai][0][m][0], acc[ai][0][m][1]); *(u32x4*)(o + HALF) = pack8(acc[ai][1][m][0], acc[ai][1][m][1]);
                float s = (sq4(acc[ai][0][m][0]) + sq4(acc[ai][0][m][1])) + (sq4(acc[ai][1][m][0]) + sq4(acc[ai][1][m][1]));
                s += shx<16>(s); s = xsum32(s);
                if (fq == 0) ((float*)(ws + WS_SSQ_CQ))[(size_t)row * 4 + wc] = s;
            EPI_ROWS_END
        } else if (pn == 1) {
            EPI_ROWS_BEGIN
                *(u32x4*)((bf16_t*)(ws + WS_R3 + R3_CKV) + (size_t)row * 128 + ct) = pack8(acc[ai][0][m][0], acc[ai][0][m][1]);
                float s = sq4(acc[ai][0][m][0]) + sq4(acc[ai][0][m][1]);
                s += shx<16>(s); s = xsum32(s);
                if (fq == 0) ((float*)(ws + WS_SSQ_CKV))[(size_t)row * 4 + wc] = s;
                if (wc == 0) { float* kr = (float*)(ws + WS_R3 + R3_KRRAW) + (size_t)row * 32 + ct; *(f32x4*)kr = acc[ai][1][m][0]; *(f32x4*)(kr + 4) = acc[ai][1][m][1]; }
            EPI_ROWS_END
        } else if (pn == 4 || pn == 5) {
            EPI_ROWS_BEGIN
                bf16_t* o = (bf16_t*)(ws + WS_R3 + R3_MEMQ) + (size_t)row * 512 + (pn - 4) * 256 + ct;
                *(u32x4*)o = pack8(acc[ai][0][m][0] * C2_MEM, acc[ai][0][m][1] * C2_MEM); *(u32x4*)(o + HALF) = pack8(acc[ai][1][m][0] * C2_MEM, acc[ai][1][m][1] * C2_MEM);
            EPI_ROWS_END
        } else {
            const int mc = (pn < 4 ? 1024 + (pn - 2) * 256 : 1536 + (pn - 6) * 256) + ct;
            EPI_ROWS_BEGIN
                bf16_t* o = (bf16_t*)(ws + WS_MIX) + (size_t)row * MIXW + mc;
                *(u32x4*)o = pack8(silu4(acc[ai][0][m][0]), silu4(acc[ai][0][m][1])); *(u32x4*)(o + HALF) = pack8(silu4(acc[ai][1][m][0]), silu4(acc[ai][1][m][1]));
            EPI_ROWS_END
        }
    }
};
struct EpiG2v {
    static constexpr bool PERM = true, AFTER_DRAIN = false; unsigned char* ws;
    __device__ __forceinline__ void operator()(const f32x4 (&acc)[2][2][4][2], const Unit& u, int wr, int wc, int fr, int fq) const {
        const int seg = u.pn >> 2, c0 = (u.pn & 3) * 256 + wc * 32 + 8 * fq;
        if (seg == 1) {
            EPI_ROWS_BEGIN
                float* o = (float*)(ws + WS_R2) + (size_t)row * 1024 + c0;
                *(f32x4*)o = acc[ai][0][m][0]; *(f32x4*)(o + 4) = acc[ai][0][m][1]; *(f32x4*)(o + HALF) = acc[ai][1][m][0]; *(f32x4*)(o + HALF + 4) = acc[ai][1][m][1];
            EPI_ROWS_END
        } else if (seg == 3) {
            EPI_ROWS_BEGIN
                bf16_t* o = (bf16_t*)(ws + WS_MIX) + (size_t)row * MIXW + c0;
                *(u32x4*)o = pack8(silu4(acc[ai][0][m][0]), silu4(acc[ai][0][m][1])); *(u32x4*)(o + HALF) = pack8(silu4(acc[ai][1][m][0]), silu4(acc[ai][1][m][1]));
            EPI_ROWS_END
        } else {
            bf16_t* base = (bf16_t*)(ws + (seg == 0 ? WS_R1 : WS_R3));
            EPI_ROWS_BEGIN
                bf16_t* o = base + (size_t)row * 1024 + c0;
                *(u32x4*)o = pack8(acc[ai][0][m][0], acc[ai][0][m][1]); *(u32x4*)(o + HALF) = pack8(acc[ai][1][m][0], acc[ai][1][m][1]);
            EPI_ROWS_END
        }
    }
};
__device__ __forceinline__ float rstd_of(const float* ssq4, float n) { const f32x4 q = *(const f32x4*)ssq4; return 1.0f / sqrtf(((q[0] + q[1]) + (q[2] + q[3])) * (1.0f / n) + RMS_EPS); }
struct EpiQv {
    static constexpr bool PERM = true, AFTER_DRAIN = false; unsigned char* ws;
    __device__ __forceinline__ void operator()(const f32x4 (&acc)[2][2][4][2], const Unit& u, int wr, int wc, int fr, int fq) const {
        EPI_ROWS_BEGIN
            const float r = rstd_of((const float*)(ws + WS_SSQ_CQ) + (size_t)row * 4, 256.f) * C2_MLA;
#pragma unroll
            for (int bj = 0; bj < 2; ++bj) {
                const int col = u.pn * BM + bj * HALF + wc * 32 + 8 * fq; const int h = col / 96, j = col - h * 96;
                f32x4 a = acc[ai][bj][m][0] * r, b = acc[ai][bj][m][1] * r;
                if (j >= 64) {
                    const int i0 = (j - 64) >> 1;
                    const f32x4 cs = *(const f32x4*)((const float*)(ws + WS_COS) + (size_t)row * 16 + i0), sn = *(const f32x4*)((const float*)(ws + WS_SIN) + (size_t)row * 16 + i0);
                    const f32x4 a2 = (f32x4){a[0] * cs[0] - a[1] * sn[0], a[0] * sn[0] + a[1] * cs[0], a[2] * cs[1] - a[3] * sn[1], a[2] * sn[1] + a[3] * cs[1]};
                    const f32x4 b2 = (f32x4){b[0] * cs[2] - b[1] * sn[2], b[0] * sn[2] + b[1] * cs[2], b[2] * cs[3] - b[3] * sn[3], b[2] * sn[3] + b[3] * cs[3]};
                    a = a2; b = b2;
                }
                *(u32x4*)((bf16_t*)(ws + WS_R1) + (size_t)row * 768 + col) = pack8(a, b);
            }
        EPI_ROWS_END
    }
};
struct EpiKnv {
    static constexpr bool PERM = true, AFTER_DRAIN = false; unsigned char* ws;
    __device__ __forceinline__ void operator()(const f32x4 (&acc)[2][2][4][2], const Unit& u, int wr, int wc, int fr, int fq) const {
        EPI_ROWS_BEGIN
            const float r = rstd_of((const float*)(ws + WS_SSQ_CKV) + (size_t)row * 4, 128.f);
            bf16_t* o = (bf16_t*)(ws + WS_R2 + R2_KN) + (size_t)row * 512 + u.pn * BM + wc * 32 + 8 * fq;
            *(u32x4*)o = pack8(acc[ai][0][m][0] * r, acc[ai][0][m][1] * r); *(u32x4*)(o + HALF) = pack8(acc[ai][1][m][0] * r, acc[ai][1][m][1] * r);
        EPI_ROWS_END
    }
};
struct EpiVtv {
    static constexpr bool PERM = true, AFTER_DRAIN = false; unsigned char* ws;
    __device__ __forceinline__ void operator()(const f32x4 (&acc)[2][2][4][2], const Unit& u, int wr, int wc, int fr, int fq) const {
#pragma unroll
        for (int bj = 0; bj < 2; ++bj) {
            const int tok = u.pn * BM + bj * HALF + wc * 32 + 8 * fq; f32x4 r0, r1;
#pragma unroll
            for (int i = 0; i < 4; ++i) { r0[i] = rstd_of((const float*)(ws + WS_SSQ_CKV) + (size_t)(tok + i) * 4, 128.f); r1[i] = rstd_of((const float*)(ws + WS_SSQ_CKV) + (size_t)(tok + 4 + i) * 4, 128.f); }
            const int b = tok >> 13, s = tok & (SEQ - 1);
            EPI_ROWS_BEGIN
                *(u32x4*)((bf16_t*)(ws + WS_R2 + R2_VT) + (size_t)(b * 512 + row) * SEQ + s) = pack8(acc[ai][bj][m][0] * r0, acc[ai][bj][m][1] * r1);
            EPI_ROWS_END
        }
    }
};
struct EpiOutv {
    static constexpr bool PERM = true, AFTER_DRAIN = false; const float* xres; float* out;
    __device__ __forceinline__ void operator()(const f32x4 (&acc)[2][2][4][2], const Unit& u, int wr, int wc, int fr, int fq) const {
        EPI_ROWS_BEGIN
#pragma unroll
            for (int bj = 0; bj < 2; ++bj) {
                const size_t off = (size_t)row * DM + u.pn * BM + bj * HALF + wc * 32 + 8 * fq;
                const f32x4 x0 = *(const f32x4*)(xres + off), x1 = *(const f32x4*)(xres + off + 4);
                *(f32x4*)(out + off) = x0 * ALPHA + acc[ai][bj][m][0]; *(f32x4*)(out + off + 4) = x1 * ALPHA + acc[ai][bj][m][1];
            }
        EPI_ROWS_END
    }
};
}


namespace att {
typedef short bf16x8 __attribute__((ext_vector_type(8)));
typedef float f32x16 __attribute__((ext_vector_type(16)));
typedef float f32x2_t __attribute__((ext_vector_type(2))); typedef __bf16 bf16x2_t __attribute__((ext_vector_type(2)));
__device__ __forceinline__ unsigned cvtpk(float lo, float hi) { f32x2_t v = {lo, hi}; bf16x2_t b = __builtin_convertvector(v, bf16x2_t); return __builtin_bit_cast(unsigned, b); }
__device__ __forceinline__ int lane_fresh() { int l; asm volatile("v_mbcnt_lo_u32_b32 %0, -1, 0\n\tv_mbcnt_hi_u32_b32 %0, -1, %0" : "=v"(l)); return l; }
#define MFMA32(a, b, c) __builtin_amdgcn_mfma_f32_32x32x16_bf16((a), (b), (c), 0, 0, 0)

template <bool MLA> struct Cfg;
template <> struct Cfg<true>  { static constexpr int DQK = 96,  DV = 64,  KP = 208, VP = 144, NKL = 2, NVL = 1; };
template <> struct Cfg<false> { static constexpr int DQK = 128, DV = 128, KP = 272, VP = 144, NKL = 2, NVL = 2; };
template <bool MLA> struct Buf { static constexpr int KB = 64 * Cfg<MLA>::KP, VB = Cfg<MLA>::DV * Cfg<MLA>::VP, SZ = KB + VB; };

template <bool MLA>
__device__ __forceinline__ void attn_unit(LAS unsigned char* lds, unsigned char* ws, int l, int b, int h, int qb, int wave) {
    typedef Cfg<MLA> C; typedef Buf<MLA> B;
    constexpr int NC = C::DQK / 16, NE = C::DV / 32;
    const int lane = lane_fresh(), tid = wave * 64 + lane, a = lane & 31, hh = lane >> 5;
    const int q0 = qb * 256, qrow = q0 + wave * 32 + a;
    const size_t grow = (size_t)b * SEQ + qrow;
    const int NT = MLA ? 4 * (qb + 1) : 4;
    const bf16_t *ks0, *ks1, *vs0, *vs1; size_t kstep, vstep; int kd0, kd1, vd0, vd1; bool k1on = true;
    if (MLA) {
        const bf16_t* KN = (const bf16_t*)(ws + WS_R2 + R2_KN); const bf16_t* KR = (const bf16_t*)(ws + WS_R2 + R2_KR); const bf16_t* VT = (const bf16_t*)(ws + WS_R2 + R2_VT);
        ks0 = KN + ((size_t)b * SEQ + (tid >> 3)) * 512 + h * 64 + (tid & 7) * 8; kd0 = (tid >> 3) * C::KP + (tid & 7) * 16;
        ks1 = KR + ((size_t)b * SEQ + ((tid & 255) >> 2)) * 32 + (tid & 3) * 8; kd1 = ((tid & 255) >> 2) * C::KP + 128 + (tid & 3) * 16; k1on = tid < 256;
        kstep = (size_t)64 * 512; vs1 = nullptr; vd1 = 0;
        vs0 = VT + ((size_t)(b * 512 + h * 64) + (tid >> 3)) * SEQ + (tid & 7) * 8; vd0 = (tid >> 3) * C::VP + (tid & 7) * 16; vstep = 64;
    } else {
        const bf16_t* KM = (const bf16_t*)(ws + WS_KMEM) + (size_t)((l * 2 + b) * 4 + h) * 256 * 128; const bf16_t* VM = (const bf16_t*)(ws + WS_VMEMT) + (size_t)((l * 2 + b) * 4 + h) * 128 * 256;
        ks0 = KM + (size_t)(tid >> 4) * 128 + (tid & 15) * 8; kd0 = (tid >> 4) * C::KP + (tid & 15) * 16;
        ks1 = ks0 + 32 * 128; kd1 = kd0 + 32 * C::KP; kstep = (size_t)64 * 128;
        vs0 = VM + (size_t)(tid >> 3) * 256 + (tid & 7) * 8; vd0 = (tid >> 3) * C::VP + (tid & 7) * 16;
        vs1 = vs0 + 64 * 256; vd1 = vd0 + 64 * C::VP; vstep = 64;
    }
    const size_t kstep1 = MLA ? (size_t)64 * 32 : kstep;
    const bf16_t* qp = MLA ? (const bf16_t*)(ws + WS_R1) + grow * 768 + h * 96 + 8 * hh : (const bf16_t*)(ws + WS_R3 + R3_MEMQ) + grow * 512 + h * 128 + 8 * hh;
    bf16x8 qf[NC];
#pragma unroll
    for (int c = 0; c < NC; ++c) qf[c] = *(const bf16x8*)(qp + 16 * c);
    const int pa = (a & 0x13) | ((a & 4) << 1) | ((a & 8) >> 1);
    const int koff = pa * C::KP + 16 * hh, voff = B::KB + a * C::VP + 16 * hh;
    f32x16 o[NE];
#pragma unroll
    for (int e = 0; e < NE; ++e)
#pragma unroll
        for (int r = 0; r < 16; ++r) o[e][r] = 0.f;
    float m_run = -1e30f, l_run = 0.f;
    v4u rk0, rk1, rv0, rv1;
    rk0 = *(const v4u*)ks0; rk1 = (v4u){0u, 0u, 0u, 0u}; if (k1on) rk1 = *(const v4u*)ks1; rv0 = *(const v4u*)vs0; if (!MLA) rv1 = *(const v4u*)vs1;
    *(LAS v4u*)(lds + kd0) = rk0; if (k1on) *(LAS v4u*)(lds + kd1) = rk1; *(LAS v4u*)(lds + B::KB + vd0) = rv0; if (!MLA) *(LAS v4u*)(lds + B::KB + vd1) = rv1;
    __syncthreads();
    for (int t = 0; t < NT; ++t) {
        const bool more = t + 1 < NT;
        if (more) { rk0 = *(const v4u*)(ks0 + (size_t)(t + 1) * kstep); if (k1on) rk1 = *(const v4u*)(ks1 + (size_t)(t + 1) * kstep1); rv0 = *(const v4u*)(vs0 + (size_t)(t + 1) * vstep); if (!MLA) rv1 = *(const v4u*)(vs1 + (size_t)(t + 1) * vstep); }
        LAS unsigned char* bufp = lds + (t & 1) * B::SZ;
        const int kv0 = 64 * t;
        const bool skip = MLA && (kv0 > q0 + wave * 32 + 31);
        if (!skip) {
            f32x16 p[2];
#pragma unroll
            for (int i = 0; i < 2; ++i) {
#pragma unroll
                for (int r = 0; r < 16; ++r) p[i][r] = 0.f;
#pragma unroll
                for (int c = 0; c < NC; ++c) { const bf16x8 kf = *(const LAS bf16x8*)(bufp + koff + i * 32 * C::KP + 32 * c); p[i] = MFMA32(kf, qf[c], p[i]); }
            }
            if (MLA && (kv0 + 63 > q0 + wave * 32)) {
#pragma unroll
                for (int i = 0; i < 2; ++i)
#pragma unroll
                    for (int r = 0; r < 16; ++r) { const int kv = kv0 + 32 * i + 16 * (r >> 3) + 8 * hh + (r & 7); if (kv > qrow) p[i][r] = -1e30f; }
            }
            float mx = p[0][0];
#pragma unroll
            for (int r = 1; r < 16; ++r) mx = fmaxf(mx, p[0][r]);
#pragma unroll
            for (int r = 0; r < 16; ++r) mx = fmaxf(mx, p[1][r]);
            mx = xmax32(mx);
            const float m_new = fmaxf(m_run, mx);
            if (__any(m_new > m_run)) {
                const float al = __builtin_amdgcn_exp2f(m_run - m_new);
                l_run *= al;
#pragma unroll
                for (int e = 0; e < NE; ++e)
#pragma unroll
                    for (int r = 0; r < 16; ++r) o[e][r] *= al;
                m_run = m_new;
            }
            float ls = 0.f;
#pragma unroll
            for (int i = 0; i < 2; ++i)
#pragma unroll
                for (int r = 0; r < 16; ++r) { p[i][r] = __builtin_amdgcn_exp2f(p[i][r] - m_run); ls += p[i][r]; }
            l_run += ls;
            bf16x8 pf[4];
#pragma unroll
            for (int s = 0; s < 4; ++s) {
                v4u w; const int i = s >> 1, r0 = 8 * (s & 1);
                w.x = cvtpk(p[i][r0], p[i][r0 + 1]); w.y = cvtpk(p[i][r0 + 2], p[i][r0 + 3]); w.z = cvtpk(p[i][r0 + 4], p[i][r0 + 5]); w.w = cvtpk(p[i][r0 + 6], p[i][r0 + 7]);
                pf[s] = __builtin_bit_cast(bf16x8, w);
            }
#pragma unroll
            for (int e = 0; e < NE; ++e)
#pragma unroll
                for (int s = 0; s < 4; ++s) { const bf16x8 vf = *(const LAS bf16x8*)(bufp + voff + e * 32 * C::VP + 32 * s); o[e] = MFMA32(vf, pf[s], o[e]); }
        }
        if (more) {
            LAS unsigned char* nb = lds + ((t + 1) & 1) * B::SZ;
            *(LAS v4u*)(nb + kd0) = rk0; if (k1on) *(LAS v4u*)(nb + kd1) = rk1; *(LAS v4u*)(nb + B::KB + vd0) = rv0; if (!MLA) *(LAS v4u*)(nb + B::KB + vd1) = rv1;
        }
        __syncthreads();
    }
    const float inv = 1.0f / xsum32(l_run);
    bf16_t* mix = (bf16_t*)(ws + WS_MIX) + grow * MIXW + (MLA ? 1024 + h * 64 : 1536 + h * 128) + 4 * hh;
#pragma unroll
    for (int e = 0; e < NE; ++e)
#pragma unroll
        for (int g = 0; g < 4; ++g) {
            v2u* pp = (v2u*)(mix + 32 * e + 8 * g); const v2u gt = *pp;
            const float g0 = bf2f(gt.x & 0xffff), g1 = bf2f(gt.x >> 16), g2 = bf2f(gt.y & 0xffff), g3 = bf2f(gt.y >> 16);
            *pp = (v2u){cvtpk(o[e][4 * g] * inv * g0, o[e][4 * g + 1] * inv * g1), cvtpk(o[e][4 * g + 2] * inv * g2, o[e][4 * g + 3] * inv * g3)};
        }
}
__device__ __forceinline__ void mla_phase(LAS unsigned char* lds, unsigned char* ws, int wave) {
    for (int p = blockIdx.x; p < 256; p += gridDim.x) { const int bh = p >> 4, j = p & 15;
        attn_unit<true>(lds, ws, 0, bh >> 3, bh & 7, 31 - j, wave); attn_unit<true>(lds, ws, 0, bh >> 3, bh & 7, j, wave); }
}
__device__ __forceinline__ void mem_phase(LAS unsigned char* lds, unsigned char* ws, int l, int wave) {
    for (int u = blockIdx.x; u < 256; u += gridDim.x) attn_unit<false>(lds, ws, l, u >> 7, (u >> 5) & 3, u & 31, wave);
}
}


namespace hg {
using att::bf16x8; using att::f32x16; using att::cvtpk; using att::lane_fresh;
typedef unsigned long long u64;
constexpr int P272 = 272, P144 = 144;
constexpr int L_KT = 0, L_QT = 64 * P272, L_KH = 2 * 64 * P272, L_VT = L_KH + 128 * P144, L_QS = L_VT + 128 * P144, H1_LDS = L_QS + 4 * 128 * 4;
__device__ __forceinline__ size_t st_off(int T0, int h, int e) { return (size_t)(T0 + (e >> 1)) * 4096 + 512 * h + 256 * (e & 1); }

__device__ __forceinline__ void h1_item(LAS unsigned char* lds, unsigned char* ws, int l, int item, int wave) {
    const int lane = lane_fresh(), tid = wave * 64 + lane, d = tid & 127, tq = tid >> 7;
    const int h = item & 7, bc = item >> 3, T0 = bc * 64;
    const size_t e0 = (size_t)(T0 + 16 * tq) * 1024 + h * 128 + d;
    const float* zp = (const float*)(ws + WS_R2) + e0; bf16_t* qp = (bf16_t*)(ws + WS_R1) + e0; const bf16_t* vp = (const bf16_t*)(ws + WS_R3) + e0;
    const float lb = ((const float*)(ws + WS_LB))[l * 1024 + h * 128 + d], omlb = 1.0f - lb;
    float bl[16], kk[16]; float run = 0.f;
#pragma unroll
    for (int i = 0; i < 16; ++i) {
        const float z = fmaxf(zp[(size_t)i * 1024], -80.f);
        const float ez = __builtin_amdgcn_exp2f(-LOG2E * z), sg = __builtin_amdgcn_rcpf(1.0f + ez);
        const float f = lb + omlb * sg; run += __logf(f); bl[i] = run; kk[i] = omlb * ez * sg;
    }
    LAS float* QS = (LAS float*)(lds + L_QS);
    QS[tq * 128 + d] = run;
    __syncthreads();
    const float s0 = QS[d], s1 = QS[128 + d], s2 = QS[256 + d], s3 = QS[384 + d];
    const float rref = s0 + s1, blast = (s0 + s1) + (s2 + s3);
    const float off = tq == 0 ? 0.f : (tq == 1 ? s0 : (tq == 2 ? s0 + s1 : (s0 + s1) + s2));
    if (tq == 3) ((float*)(ws + WS_DECAY))[(size_t)bc * 1024 + h * 128 + d] = __expf(blast);
    unsigned khp[8], vpk[8];
#pragma unroll
    for (int i = 0; i < 16; i += 2) {
        float kh2[2]; unsigned short vv[2];
#pragma unroll
        for (int j = 0; j < 2; ++j) {
            const int ii = i + j, t = 16 * tq + ii;
            const float b = bl[ii] + off, q = bf2f(qp[(size_t)ii * 1024]);
            const float ebr = __builtin_amdgcn_exp2f(LOG2E * (b - rref));
            qp[(size_t)ii * 1024] = (bf16_t)f2bf(q * __builtin_amdgcn_exp2f(LOG2E * b));
            *(LAS bf16_t*)(lds + L_QT + t * P272 + 2 * d) = (bf16_t)f2bf(q * ebr);
            *(LAS bf16_t*)(lds + L_KT + t * P272 + 2 * d) = (bf16_t)f2bf(kk[ii] * __builtin_amdgcn_exp2f(LOG2E * (rref - b)));
            kh2[j] = kk[ii] * __builtin_amdgcn_exp2f(LOG2E * (blast - b));
            vv[j] = vp[(size_t)ii * 1024];
        }
        khp[i >> 1] = cvtpk(kh2[0], kh2[1]); vpk[i >> 1] = (unsigned)vv[0] | ((unsigned)vv[1] << 16);
    }
    *(LAS v4u*)(lds + L_KH + d * P144 + 32 * tq) = (v4u){khp[0], khp[1], khp[2], khp[3]}; *(LAS v4u*)(lds + L_KH + d * P144 + 32 * tq + 16) = (v4u){khp[4], khp[5], khp[6], khp[7]};
    *(LAS v4u*)(lds + L_VT + d * P144 + 32 * tq) = (v4u){vpk[0], vpk[1], vpk[2], vpk[3]}; *(LAS v4u*)(lds + L_VT + d * P144 + 32 * tq + 16) = (v4u){vpk[4], vpk[5], vpk[6], vpk[7]};
    __syncthreads();
    const int a = lane & 31, hh = lane >> 5, ei = wave >> 1, ti = wave & 1;
    f32x16 y;
#pragma unroll
    for (int r = 0; r < 16; ++r) y[r] = 0.f;
    for (int si = 0; si <= ti; ++si) {
        f32x16 x;
#pragma unroll
        for (int r = 0; r < 16; ++r) x[r] = 0.f;
#pragma unroll
        for (int c = 0; c < 8; ++c) {
            const bf16x8 kf = *(const LAS bf16x8*)(lds + L_KT + (32 * si + a) * P272 + 32 * c + 16 * hh);
            const bf16x8 qf = *(const LAS bf16x8*)(lds + L_QT + (32 * ti + a) * P272 + 32 * c + 16 * hh);
            x = MFMA32(kf, qf, x);
        }
        if (si == ti) {
#pragma unroll
            for (int r = 0; r < 16; ++r) { const int s = (r & 3) + 8 * (r >> 2) + 4 * hh; if (s > a) x[r] = 0.f; }
        }
#pragma unroll
        for (int ks = 0; ks < 2; ++ks) {
            v4u w; w.x = cvtpk(x[8 * ks], x[8 * ks + 1]); w.y = cvtpk(x[8 * ks + 2], x[8 * ks + 3]); w.z = cvtpk(x[8 * ks + 4], x[8 * ks + 5]); w.w = cvtpk(x[8 * ks + 6], x[8 * ks + 7]);
            const LAS unsigned char* vb = lds + L_VT + (32 * ei + a) * P144 + 64 * si + 32 * ks + 8 * hh;
            const v2u lo = *(const LAS v2u*)vb, hi = *(const LAS v2u*)(vb + 16);
            y = MFMA32(__builtin_bit_cast(bf16x8, ((v4u){lo.x, lo.y, hi.x, hi.y})), __builtin_bit_cast(bf16x8, w), y);
        }
    }
    {
        bf16_t* op = (bf16_t*)(ws + WS_R3) + (size_t)(T0 + 32 * ti + a) * 1024 + h * 128 + 32 * ei + 4 * hh;
#pragma unroll
        for (int g = 0; g < 4; ++g) *(v2u*)(op + 8 * g) = (v2u){cvtpk(y[4 * g], y[4 * g + 1]), cvtpk(y[4 * g + 2], y[4 * g + 3])};
    }
#pragma unroll
    for (int dd = 0; dd < 2; ++dd) {
        const int di = 2 * ti + dd;
#pragma unroll
        for (int r = 0; r < 16; ++r) y[r] = 0.f;
#pragma unroll
        for (int ks = 0; ks < 4; ++ks) {
            const bf16x8 kh = *(const LAS bf16x8*)(lds + L_KH + (32 * di + a) * P144 + 32 * ks + 16 * hh);
            const bf16x8 vf = *(const LAS bf16x8*)(lds + L_VT + (32 * ei + a) * P144 + 32 * ks + 16 * hh);
            y = MFMA32(kh, vf, y);
        }
        unsigned char* sp = ws + WS_R2 + st_off(T0, h, 32 * ei + a) + 2 * (32 * di + 4 * hh);
#pragma unroll
        for (int g = 0; g < 4; ++g) *(v2u*)(sp + 16 * g) = (v2u){cvtpk(y[4 * g], y[4 * g + 1]), cvtpk(y[4 * g + 2], y[4 * g + 3])};
    }
    __syncthreads();
}
__device__ __forceinline__ void h1_phase(LAS unsigned char* lds, unsigned char* ws, int l, int wave) {
    for (int it = blockIdx.x; it < (T / 64) * 8; it += gridDim.x) h1_item(lds, ws, l, it, wave);
}

__device__ __forceinline__ void h2_phase(unsigned char* ws, int wave) {
    const int lane = lane_fresh();
    for (int row = blockIdx.x * NWAVES + wave; row < NB * 8 * 128; row += gridDim.x * NWAVES) {
        const int e = row & 127, h = (row >> 7) & 7, b = row >> 10;
        unsigned char* sp = ws + WS_R2 + st_off(b * SEQ, h, e) + 4 * lane;
        const float* dc = (const float*)(ws + WS_DECAY) + (size_t)b * 128 * 1024 + h * 128 + 2 * lane;
        float s0 = 0.f, s1 = 0.f;
        for (int c0 = 0; c0 < NCH; c0 += 8) {
            unsigned dsv[8]; float2 dv[8];
#pragma unroll
            for (int j = 0; j < 8; ++j) { dsv[j] = *(const unsigned*)(sp + (size_t)(c0 + j) * 64 * 4096); dv[j] = *(const float2*)(dc + (size_t)(c0 + j) * 1024); }
#pragma unroll
            for (int j = 0; j < 8; ++j) {
                *(unsigned*)(sp + (size_t)(c0 + j) * 64 * 4096) = cvtpk(s0, s1);
                s0 = fmaf(dv[j].x, s0, bf2f(dsv[j] & 0xffff)); s1 = fmaf(dv[j].y, s1, bf2f(dsv[j] >> 16));
            }
        }
    }
}

constexpr int L3_ST = 0, L3_QH = 128 * P272, L3_OT = L3_QH + 64 * P272, OTP = 132, H3_LDS = L3_OT + 64 * OTP * 4;
__device__ __forceinline__ void h3_item(LAS unsigned char* lds, unsigned char* ws, const float* out_g, int item, int wave) {
    const int lane = lane_fresh(), tid = wave * 64 + lane;
    const int h = item & 7, bc = item >> 3, T0 = bc * 64;
#pragma unroll
    for (int j = 0; j < 4; ++j) { const int idx = tid + 512 * j, e = idx >> 4, ch = idx & 15; *(LAS v4u*)(lds + L3_ST + e * P272 + 16 * ch) = *(const v4u*)(ws + WS_R2 + st_off(T0, h, e) + 16 * ch); }
#pragma unroll
    for (int j = 0; j < 2; ++j) { const int idx = tid + 512 * j, t = idx >> 4, ch = idx & 15; *(LAS v4u*)(lds + L3_QH + t * P272 + 16 * ch) = *(const v4u*)((const bf16_t*)(ws + WS_R1) + (size_t)(T0 + t) * 1024 + h * 128 + 8 * ch); }
    __syncthreads();
    {
        const int a = lane & 31, hh = lane >> 5, ei = wave >> 1, ti = wave & 1;
        f32x16 y;
#pragma unroll
        for (int r = 0; r < 16; ++r) y[r] = 0.f;
#pragma unroll
        for (int c = 0; c < 8; ++c) {
            const bf16x8 sf = *(const LAS bf16x8*)(lds + L3_ST + (32 * ei + a) * P272 + 32 * c + 16 * hh);
            const bf16x8 qf = *(const LAS bf16x8*)(lds + L3_QH + (32 * ti + a) * P272 + 32 * c + 16 * hh);
            y = MFMA32(sf, qf, y);
        }
        LAS float* ot = (LAS float*)(lds + L3_OT) + (32 * ti + a) * OTP + 32 * ei + 4 * hh;
#pragma unroll
        for (int g = 0; g < 4; ++g) *(LAS f32x4*)(ot + 8 * g) = (f32x4){y[4 * g], y[4 * g + 1], y[4 * g + 2], y[4 * g + 3]};
    }
    __syncthreads();
    {
        const int t = tid >> 3, part = tid & 7;
        const LAS float* ot = (const LAS float*)(lds + L3_OT) + t * OTP + 16 * part;
        const size_t go = (size_t)(T0 + t) * 1024 + h * 128 + 16 * part;
        const v4u i0 = *(const v4u*)((const bf16_t*)(ws + WS_R3) + go), i1 = *(const v4u*)((const bf16_t*)(ws + WS_R3) + go + 8);
        const unsigned iw[8] = {i0.x, i0.y, i0.z, i0.w, i1.x, i1.y, i1.z, i1.w};
        float o[16]; float ss = 0.f;
#pragma unroll
        for (int j = 0; j < 8; ++j) { o[2 * j] = ot[2 * j] + bf2f(iw[j] & 0xffff); o[2 * j + 1] = ot[2 * j + 1] + bf2f(iw[j] >> 16); ss += o[2 * j] * o[2 * j] + o[2 * j + 1] * o[2 * j + 1]; }
        ss += shx<1>(ss); ss += shx<2>(ss); ss += shx<4>(ss);
        const float rs = 1.0f / sqrtf(ss * (1.0f / 128.0f) + RMS_EPS);
        bf16_t* mix = (bf16_t*)(ws + WS_MIX) + (size_t)(T0 + t) * MIXW + h * 128 + 16 * part;
        const v4u g0 = *(const v4u*)mix, g1 = *(const v4u*)(mix + 8);
        const unsigned gw[8] = {g0.x, g0.y, g0.z, g0.w, g1.x, g1.y, g1.z, g1.w};
        unsigned ow[8];
#pragma unroll
        for (int j = 0; j < 8; ++j) ow[j] = cvtpk(o[2 * j] * rs * out_g[16 * part + 2 * j] * bf2f(gw[j] & 0xffff), o[2 * j + 1] * rs * out_g[16 * part + 2 * j + 1] * bf2f(gw[j] >> 16));
        *(v4u*)mix = (v4u){ow[0], ow[1], ow[2], ow[3]}; *(v4u*)(mix + 8) = (v4u){ow[4], ow[5], ow[6], ow[7]};
    }
    __syncthreads();
}
__device__ __forceinline__ void h3_phase(LAS unsigned char* lds, unsigned char* ws, const float* out_g, int wave) {
    for (int it = blockIdx.x; it < (T / 64) * 8; it += gridDim.x) h3_item(lds, ws, out_g, it, wave);
}
}

constexpr int LDS_BYTES = 147456;
__device__ __forceinline__ float wave_sum(float v) {
    v += shx<1>(v); v += shx<2>(v); v += shx<4>(v); v += shx<8>(v); v += shx<16>(v);
    return xsum32(v);
}

__device__ __forceinline__ void conv_layer_weights(const Ptrs& p, int l, LAS float* scr, int gw, int ngw, int lane) {
    constexpr int I_IN = (DM / 64) * (NWIN / 32), I_OUT = (MIXW / 64) * (DM / 32);
    bf16_t* win = (bf16_t*)(p.ws + WS_WIN); bf16_t* wout = (bf16_t*)(p.ws + WS_WOUT);
    for (int it = gw; it < I_IN + I_OUT; it += ngw) {
        if (it < I_IN) transpose_item<1>(p.w_in + (size_t)l * DM * INW, DM, INW, NWIN, nullptr, win, scr, it, lane);
        else transpose_item<0>(p.w_out + (size_t)l * MIXW * DM, MIXW, DM, DM, nullptr, wout, scr, it - I_IN, lane);
    }
}

__device__ __forceinline__ void phase_prologue(const Ptrs& p, LAS unsigned char* lds, int wave) {
    const int lane = att::lane_fresh(), gw = blockIdx.x * NWAVES + wave, ngw = gridDim.x * NWAVES;
    LAS float* scr = (LAS float*)(lds + wave * 16384);
    conv_layer_weights(p, 0, scr, gw, ngw, lane);
    {
        constexpr int I_UQ = (256 / 64) * (768 / 32), I_UK = (128 / 64) * (512 / 32);
        for (int it = gw; it < 2 * (I_UQ + 2 * I_UK); it += ngw) {
            const int l = it / (I_UQ + 2 * I_UK); int r = it % (I_UQ + 2 * I_UK);
            if (r < I_UQ) { transpose_item<2>(p.w_uq + (size_t)l * 256 * 768, 256, 768, 768, p.q_norm + l * 256, (bf16_t*)(p.ws + WS_WUQ) + (size_t)l * 768 * 256, scr, r, lane); continue; } r -= I_UQ;
            if (r < I_UK) { transpose_item<0>(p.w_uk + (size_t)l * 128 * 512, 128, 512, 512, p.kv_norm + l * 128, (bf16_t*)(p.ws + WS_WUK) + (size_t)l * 512 * 128, scr, r, lane); continue; } r -= I_UK;
            transpose_item<0>(p.w_uv + (size_t)l * 128 * 512, 128, 512, 512, p.kv_norm + l * 128, (bf16_t*)(p.ws + WS_WUV) + (size_t)l * 512 * 128, scr, r, lane);
        }
    }
    for (int m = gw; m < T; m += ngw) {
        const f32x4* xr = (const f32x4*)(p.x + (size_t)m * DM) + lane; v2u* o = (v2u*)((bf16_t*)(p.ws + WS_XN) + (size_t)m * DM) + lane;
#pragma unroll
        for (int j = 0; j < 4; ++j) { const f32x4 v = xr[64 * j]; v2u w; w.x = pk2(v.x, v.y); w.y = pk2(v.z, v.w); o[64 * j] = w; }
    }
    const int gt = gw * 64 + lane, ngt = ngw * 64;
    for (int i = gt; i < T * 16; i += ngt) {
        const int t = i >> 4, j = i & 15;
        const double inv = pow(10000.0, -(double)j / 16.0); const double ang = (double)p.pos[t] * inv;
        ((float*)(p.ws + WS_COS))[i] = (float)cos(ang); ((float*)(p.ws + WS_SIN))[i] = (float)sin(ang);
    }
    for (int i = gt; i < 1024; i += ngt) {
        float* lb = (float*)(p.ws + WS_LB); lb[i] = 0.f;
        const float a = p.lb_logits[i], b = p.lb_logits[1024 + i]; lb[1024 + i] = 1.0f / (1.0f + expf(a - b));
    }
    for (int i = gt; i < 2 * 2 * 512 * 512; i += ngt) {
        const int c = i & 511, r = (i >> 9) & 511, kv = (i >> 18) & 1, l = i >> 19;
        const float* w = (kv ? p.w_mv : p.w_mk) + (size_t)l * 1024 * 512 + c; const float* mr = p.mem + (size_t)r * 1024;
        float acc = 0.f;
        for (int k = 0; k < 1024; ++k) acc = fmaf(mr[k], w[(size_t)k * 512], acc);
        const int b = r >> 8, m = r & 255, h = c >> 7, d = c & 127;
        if (kv == 0) ((bf16_t*)(p.ws + WS_KMEM))[((size_t)((l * 2 + b) * 4 + h) * 256 + m) * 128 + d] = (bf16_t)f2bf(acc);
        else ((bf16_t*)(p.ws + WS_VMEMT))[((size_t)((l * 2 + b) * 4 + h) * 128 + d) * 256 + m] = (bf16_t)f2bf(acc);
    }
}

__device__ __forceinline__ void phase_ln(const Ptrs& p, int l, LAS unsigned char* lds, int wave) {
    const int lane = att::lane_fresh(), gw = blockIdx.x * NWAVES + wave, ngw = gridDim.x * NWAVES;
    const float* g = p.ln_g + l * DM; const float* bt = p.ln_b + l * DM;
    for (int m = gw; m < T; m += ngw) {
        f32x4* xr = (f32x4*)(p.out + (size_t)m * DM) + lane;
        f32x4 v[4]; float s = 0.f;
#pragma unroll
        for (int j = 0; j < 4; ++j) { v[j] = xr[64 * j]; s += (v[j].x + v[j].y) + (v[j].z + v[j].w); }
        const float mean = wave_sum(s) * (1.f / DM); float s2 = 0.f;
#pragma unroll
        for (int j = 0; j < 4; ++j) { v[j] = v[j] - mean; s2 += (v[j].x * v[j].x + v[j].y * v[j].y) + (v[j].z * v[j].z + v[j].w * v[j].w); }
        const float rstd = 1.f / sqrtf(wave_sum(s2) * (1.f / DM) + LN_EPS);
        v2u* o = (v2u*)((bf16_t*)(p.ws + WS_XN) + (size_t)m * DM) + lane;
#pragma unroll
        for (int j = 0; j < 4; ++j) {
            const f32x4 gg = *((const f32x4*)g + lane + 64 * j), bb = *((const f32x4*)bt + lane + 64 * j);
            const f32x4 y = v[j] * rstd * gg + bb; xr[64 * j] = y;
            v2u w; w.x = pk2(y.x, y.y); w.y = pk2(y.z, y.w); o[64 * j] = w;
        }
    }
    if (l + 1 < DEPTH) conv_layer_weights(p, l + 1, (LAS float*)(lds + wave * 16384), gw, ngw, lane);
}


__device__ __forceinline__ void krope_phase(unsigned char* ws, int wave) {
    const int lane = att::lane_fresh();
    for (int i = (blockIdx.x * NWAVES + wave) * 64 + lane; i < T * 16; i += gridDim.x * NTHR) {
        const int t = i >> 4, j = i & 15;
        const float* raw = (const float*)(ws + WS_R3 + R3_KRRAW) + (size_t)t * 32 + 2 * j;
        const float c = ((const float*)(ws + WS_COS))[i], s = ((const float*)(ws + WS_SIN))[i];
        const float a = raw[0], b = raw[1];
        *(unsigned*)((bf16_t*)(ws + WS_R2 + R2_KR) + (size_t)t * 32 + 2 * j) = pk2(a * c - b * s, a * s + b * c);
    }
}


#define XB_TMO      128
#define XB_XCNT(j)  (256  + 64 * (j))
#define XB_XSUB(j)  (1280 + 64 * (j))
#define XB_XGEN(j)  (2304 + 64 * (j))
#define XB_TOP      3328
#define XB_TOPGEN   3392
#define XCD_BAR_WORDS 3456
#define XB_SPIN_CAP (1u << 18)
__device__ __forceinline__ unsigned xb_ld(unsigned* p)              { return __hip_atomic_load(p, __ATOMIC_RELAXED, __HIP_MEMORY_SCOPE_AGENT); }
__device__ __forceinline__ unsigned xb_add(unsigned* p, unsigned v) { return __hip_atomic_fetch_add(p, v, __ATOMIC_RELAXED, __HIP_MEMORY_SCOPE_AGENT); }
__device__ __forceinline__ unsigned xb_xcc_id() { return (unsigned)__builtin_amdgcn_s_getreg((3 << 11) | 20) & 0xFu; }
#define XB_SPIN(cond, bar) do { unsigned _sp = 0; while (cond) { __builtin_amdgcn_s_sleep(1); \
    if ((++_sp & 255u) == 0u) { if (xb_ld(&(bar)[XB_TMO])) break; if (_sp > XB_SPIN_CAP) { atomicAdd(&(bar)[XB_TMO], 1u); break; } } } } while (0)
struct XcdBarrier { unsigned* bar; unsigned x; volatile LAS unsigned* st; };
__device__ __forceinline__ void xcd_barrier_complete(unsigned* bar, unsigned x, unsigned& nloc, unsigned& nx) {
    const unsigned G = gridDim.x * gridDim.y * gridDim.z;
    unsigned sum, cnt, mine, sp = 0u;
    for (;;) {
        sum = 0u; cnt = 0u; mine = 0u;
#pragma unroll
        for (unsigned j = 0; j < 16; ++j) { const unsigned c = xb_ld(&bar[XB_XCNT(j)]); sum += c; cnt += (c > 0u) ? 1u : 0u; mine = (j == x) ? c : mine; }
        if (sum == G) break;
        __builtin_amdgcn_s_sleep(1);
        if ((++sp & 255u) == 0u) { if (xb_ld(&bar[XB_TMO])) break; if (sp > XB_SPIN_CAP) { atomicAdd(&bar[XB_TMO], 1u); break; } }
    }
    nloc = mine > 0u ? mine : 1u; nx = cnt > 0u ? cnt : 1u;
}
__device__ __forceinline__ void xcd_barrier(const XcdBarrier& b, const int wave) {
    asm volatile("s_waitcnt vmcnt(0)" ::: "memory");
    __syncthreads();
    if (wave == 0 && att::lane_fresh() == 0) {
        unsigned* bar = b.bar;
        __builtin_amdgcn_s_waitcnt(0);
        unsigned nloc = b.st[0], nx = b.st[1];
        if (nloc == 0u) { xcd_barrier_complete(bar, b.x, nloc, nx); b.st[0] = nloc; b.st[1] = nx; }
        const unsigned old = xb_add(&bar[XB_XSUB(b.x)], 1u);
        const unsigned gen = old / nloc;
        if (old + 1u == (gen + 1u) * nloc) {
            __builtin_amdgcn_fence(__ATOMIC_RELEASE, "agent");
            asm volatile("s_waitcnt vmcnt(0)" ::: "memory");
            const unsigned og = xb_add(&bar[XB_TOP], 1u);
            const unsigned tg = og / nx;
            if (og + 1u == (tg + 1u) * nx) xb_add(&bar[XB_TOPGEN], 1u);
            else XB_SPIN(xb_ld(&bar[XB_TOPGEN]) == tg, bar);
            __builtin_amdgcn_fence(__ATOMIC_ACQUIRE, "agent");
            xb_add(&bar[XB_XGEN(b.x)], 1u);
            asm volatile("s_waitcnt vmcnt(0)" ::: "memory");
        } else {
            XB_SPIN(xb_ld(&bar[XB_XGEN(b.x)]) == gen, bar);
            __builtin_amdgcn_fence(__ATOMIC_ACQUIRE, "agent");
            asm volatile("s_waitcnt vmcnt(0)" ::: "memory");
        }
    }
    __syncthreads();
}
constexpr int LDS_MISC = 131072;

namespace cg = cooperative_groups;
struct Args { Ptrs p; };
#define CAS __attribute__((address_space(4)))
__device__ __forceinline__ Ptrs load_ptrs(const CAS Args* ka) {
    Ptrs p; p.x = ka->p.x; p.mem = ka->p.mem; p.pos = ka->p.pos; p.w_in = ka->p.w_in; p.lb_logits = ka->p.lb_logits; p.out_norm = ka->p.out_norm; p.q_norm = ka->p.q_norm; p.kv_norm = ka->p.kv_norm;
    p.w_uq = ka->p.w_uq; p.w_uk = ka->p.w_uk; p.w_uv = ka->p.w_uv; p.w_mk = ka->p.w_mk; p.w_mv = ka->p.w_mv; p.w_out = ka->p.w_out; p.ln_g = ka->p.ln_g; p.ln_b = ka->p.ln_b; p.out = ka->p.out; p.ws = ka->p.ws; return p;
}
#define PHASE_ENV() const CAS Args* ka = (const CAS Args*)__builtin_amdgcn_kernarg_segment_ptr(); asm volatile("" : "+s"(ka)); int lf = l; asm volatile("" : "+s"(lf)); unsigned char* ws = ka->p.ws; (void)lf; (void)ws
#define GRID_BAR() xcd_barrier(xb, wave)
template <int l> __device__ __forceinline__ void layer_program(LAS unsigned char* lds, const int wave, const XcdBarrier& xb) {
        {
            PHASE_ENV();
            pg8::Gemm g{(const bf16_t*)(ws + WS_XN), (const bf16_t*)(ws + WS_WIN) + (size_t)G1_ROW0 * DM, T, G1_N, DM, DM, DM}; pg8::StaticOrder S; S.init(T, G1_N, gridDim.x, blockIdx.x);
            pg8::gemm_phase<pg8::EpiG1v, pg8::StaticOrder, true, true>(lds, g, S, pg8::EpiG1v{ws}, wave);
        }
        GRID_BAR();
        {
            { PHASE_ENV(); pg8::Gemm g{(const bf16_t*)(ws + WS_R3 + R3_CQ), (const bf16_t*)(ws + WS_WUQ) + (size_t)lf * 768 * 256, T, 768, 256, 256, 256}; pg8::StaticOrder S; S.init(T, 768, gridDim.x, blockIdx.x);
              pg8::gemm_phase<pg8::EpiQv, pg8::StaticOrder, true, true>(lds, g, S, pg8::EpiQv{ws}, wave); }
            __syncthreads();
            { PHASE_ENV(); pg8::Gemm g{(const bf16_t*)(ws + WS_R3 + R3_CKV), (const bf16_t*)(ws + WS_WUK) + (size_t)lf * 512 * 128, T, 512, 128, 128, 128}; pg8::StaticOrder S; S.init(T, 512, gridDim.x, blockIdx.x);
              pg8::gemm_phase<pg8::EpiKnv, pg8::StaticOrder, true, true>(lds, g, S, pg8::EpiKnv{ws}, wave); }
            __syncthreads();
            { PHASE_ENV(); pg8::Gemm g{(const bf16_t*)(ws + WS_WUV) + (size_t)lf * 512 * 128, (const bf16_t*)(ws + WS_R3 + R3_CKV), 512, T, 128, 128, 128}; pg8::StaticOrder S; S.init(512, T, gridDim.x, blockIdx.x);
              pg8::gemm_phase<pg8::EpiVtv, pg8::StaticOrder, true, true>(lds, g, S, pg8::EpiVtv{ws}, wave); }
            __syncthreads();
            { PHASE_ENV(); krope_phase(ws, wave); }
            { PHASE_ENV(); att::mem_phase(lds, ws, lf, wave); }
        }
        GRID_BAR();
        { PHASE_ENV(); att::mla_phase(lds, ws, wave); }
        GRID_BAR();
        {
            PHASE_ENV();
            pg8::Gemm g{(const bf16_t*)(ws + WS_XN), (const bf16_t*)(ws + WS_WIN) + (size_t)G2_ROW0 * DM, T, G2_N, DM, DM, DM}; pg8::StaticOrder S; S.init(T, G2_N, gridDim.x, blockIdx.x);
            pg8::gemm_phase<pg8::EpiG2v, pg8::StaticOrder, true, true>(lds, g, S, pg8::EpiG2v{ws}, wave);
        }
        GRID_BAR();
        { PHASE_ENV(); hg::h1_phase(lds, ws, lf, wave); }
        GRID_BAR();
        { PHASE_ENV(); hg::h2_phase(ws, wave); }
        GRID_BAR();
        { PHASE_ENV(); hg::h3_phase(lds, ws, ka->p.out_norm + lf * 128, wave); }
        GRID_BAR();
        {
            PHASE_ENV();
            pg8::Gemm g{(const bf16_t*)(ws + WS_MIX), (const bf16_t*)(ws + WS_WOUT), T, DM, MIXW, MIXW, MIXW}; pg8::StaticOrder S; S.init(T, DM, gridDim.x, blockIdx.x);
            float* outp = ka->p.out; const float* xres = lf == 0 ? ka->p.x : (const float*)outp;
            pg8::gemm_phase<pg8::EpiOutv, pg8::StaticOrder, true, true>(lds, g, S, pg8::EpiOutv{xres, outp}, wave);
        }
        GRID_BAR();
        { PHASE_ENV(); const Ptrs p = load_ptrs(ka); phase_ln(p, lf, lds, wave); }
}
__global__ void __launch_bounds__(NTHR, 2) mk(Args a) {
    extern __shared__ __attribute__((aligned(16))) unsigned char lds_raw[];
    LAS unsigned char* lds = (LAS unsigned char*)lds_raw;
    const int wave = __builtin_amdgcn_readfirstlane(threadIdx.x >> 6);
    cg::grid_group grid = cg::this_grid();
    if (threadIdx.x < 16) ((LAS unsigned*)(lds + LDS_MISC))[threadIdx.x] = 0u;
    __syncthreads();
    XcdBarrier xb;
    { const int l = 0; PHASE_ENV(); xb.bar = (unsigned*)(ws + WS_CTL) + 4096; xb.x = xb_xcc_id(); xb.st = (volatile LAS unsigned*)(lds + LDS_MISC);
      if (threadIdx.x == 0) (void)xb_add(&xb.bar[XB_XCNT(xb.x)], 1u);
      const Ptrs p = load_ptrs(ka); phase_prologue(p, lds, wave); }
    grid.sync();
    layer_program<0>(lds, wave, xb);
    GRID_BAR();
    layer_program<1>(lds, wave, xb);
}

extern "C" void kernel_launch(void* const* d_in, const int* in_sizes, int n_in, void* d_out, int out_size, void* d_ws, size_t ws_size, hipStream_t stream) {
    static int grid = 0;
    if (grid == 0) {
        if (n_in != 16 || in_sizes[0] != T * DM || out_size != T * DM || ws_size < WS_END) { fprintf(stderr, "kernel_launch: unexpected shapes (n_in %d, ws %zu)\n", n_in, ws_size); grid = -1; return; }
        if (hipFuncSetAttribute((const void*)mk, hipFuncAttributeMaxDynamicSharedMemorySize, LDS_BYTES) != hipSuccess) { fprintf(stderr, "kernel_launch: hipFuncSetAttribute failed\n"); grid = -1; return; }
        int dev = 0, cus = 0, per_cu = 0;
        hipGetDevice(&dev); hipDeviceGetAttribute(&cus, hipDeviceAttributeMultiprocessorCount, dev);
        hipOccupancyMaxActiveBlocksPerMultiprocessor(&per_cu, (const void*)mk, NTHR, LDS_BYTES);
        if (per_cu < 1 || cus < 1) { fprintf(stderr, "kernel_launch: occupancy query gave %d blocks/CU on %d CUs\n", per_cu, cus); grid = -1; return; }
        grid = cus;
    }
    if (grid < 0) return;
    Args a{};
    a.p.x = (const float*)d_in[0]; a.p.mem = (const float*)d_in[1]; a.p.pos = (const int*)d_in[2]; a.p.w_in = (const float*)d_in[3];
    a.p.lb_logits = (const float*)d_in[4]; a.p.out_norm = (const float*)d_in[5]; a.p.q_norm = (const float*)d_in[6]; a.p.kv_norm = (const float*)d_in[7];
    a.p.w_uq = (const float*)d_in[8]; a.p.w_uk = (const float*)d_in[9]; a.p.w_uv = (const float*)d_in[10]; a.p.w_mk = (const float*)d_in[11]; a.p.w_mv = (const float*)d_in[12];
    a.p.w_out = (const float*)d_in[13]; a.p.ln_g = (const float*)d_in[14]; a.p.ln_b = (const float*)d_in[15];
    a.p.out = (float*)d_out; a.p.ws = (unsigned char*)d_ws;
    if (hipMemsetAsync((char*)d_ws + WS_CTL, 0, CTL_BYTES, stream) != hipSuccess) { fprintf(stderr, "kernel_launch: hipMemsetAsync failed\n"); return; }
    void* args[] = {&a};
    const hipError_t e = hipLaunchCooperativeKernel((const void*)mk, dim3(grid), dim3(NTHR), args, LDS_BYTES, stream);
    if (e != hipSuccess) fprintf(stderr, "kernel_launch: cooperative launch failed: %s (grid %d)\n", hipGetErrorString(e), grid);
}
```
